# Optimizing an MI355X kernel written in HIP

```python
import numpy as np
import jax
import jax.numpy as jnp
from jax import lax

D_MODEL = 2048
BATCH = 2
SEQ = 16384
DEPTH = 1

PLE_DIM = 256
HEAD_DIM = 64
N_HEADS = D_MODEL // 128
N_KV_HEADS = max(1, N_HEADS // 8)
GQA_GROUP = N_HEADS // N_KV_HEADS
WINDOW = 128
M_HEADS = 4
M_DV = D_MODEL // (2 * M_HEADS)
M_DQK = M_DV // 2
M_CHUNK = 64
GATE_SOFTCAP = 15.0
N_EXPERTS = 64
TOP_K = 8
D_EXPERT = D_MODEL // 4
D_SHARED = D_MODEL // 4
ROUTED_SCALE = 2.5
MOE_BLOCK = 256
LN_EPS = 1e-5
RMS_EPS = 1e-6
DEEPNORM_ALPHA = (2.0 * DEPTH) ** 0.25
DEEPNORM_BETA = (8.0 * DEPTH) ** -0.25

ATTN_Q_W = N_HEADS * HEAD_DIM
ATTN_KV_W = N_KV_HEADS * HEAD_DIM
M_QK_W = M_HEADS * M_DQK
M_V_W = M_HEADS * M_DV
IN_SIZES = (ATTN_Q_W, ATTN_KV_W, ATTN_KV_W, M_QK_W, M_QK_W, M_V_W, M_V_W, M_HEADS, M_HEADS, D_MODEL, D_MODEL)
IN_COLS = sum(IN_SIZES)

kernel_name = 'hybrid_swa_mlstm_moe_deepnorm'


def layer_norm(x, g, b):
    xf = x.astype(jnp.float32)
    mu = jnp.mean(xf, axis=-1, keepdims=True)
    var = jnp.mean(jnp.square(xf - mu), axis=-1, keepdims=True)
    y = (xf - mu) * lax.rsqrt(var + LN_EPS) * g.astype(jnp.float32) + b.astype(jnp.float32)
    return y.astype(x.dtype)


def soft_cap(z):
    return GATE_SOFTCAP * jnp.tanh(z / GATE_SOFTCAP)


def alibi_slopes():
    return jnp.exp2(-8.0 / N_HEADS * jnp.arange(1, N_HEADS + 1, dtype=jnp.float32))


def swa_sink_attention(q, k, v, sinks):
    B, S = q.shape[0], q.shape[1]
    nb = S // WINDOW
    qb = q.reshape(B, nb, WINDOW, N_KV_HEADS, GQA_GROUP, HEAD_DIM)
    kb = k.reshape(B, nb, WINDOW, N_KV_HEADS, HEAD_DIM)
    vb = v.reshape(B, nb, WINDOW, N_KV_HEADS, HEAD_DIM)
    pad = ((0, 0), (1, 0), (0, 0), (0, 0), (0, 0))
    kk = jnp.concatenate([jnp.pad(kb[:, :-1], pad), kb], axis=2)
    vv = jnp.concatenate([jnp.pad(vb[:, :-1], pad), vb], axis=2)
    s = jnp.einsum('bnqhgd,bnkhd->bnhgqk', qb, kk).astype(jnp.float32) * (HEAD_DIM ** -0.5)
    qi = jnp.arange(WINDOW)[:, None]
    kj = jnp.arange(2 * WINDOW)[None, :]
    dist = qi - kj + WINDOW
    in_band = (dist >= 0) & (dist < WINDOW)
    key_pos = jnp.arange(nb)[:, None] * WINDOW - WINDOW + jnp.arange(2 * WINDOW)[None, :]
    mask = in_band[None] & (key_pos >= 0)[:, None, :]
    slopes = alibi_slopes().reshape(N_KV_HEADS, GQA_GROUP)
    bias = -slopes[:, :, None, None] * dist.astype(jnp.float32)
    s = jnp.where(mask[None, :, None, None], s + bias, -jnp.inf)
    sink = jnp.broadcast_to(sinks.astype(jnp.float32).reshape(N_KV_HEADS, GQA_GROUP, 1, 1), s.shape[:-1] + (1,))
    probs = jax.nn.softmax(jnp.concatenate([s, sink], axis=-1), axis=-1)[..., :-1]
    o = jnp.einsum('bnhgqk,bnkhd->bnqhgd', probs.astype(v.dtype), vv)
    return o.reshape(B, S, N_HEADS * HEAD_DIM)


def _to_chunks(a, nc):
    B = a.shape[0]
    a = a.reshape((B, nc, M_CHUNK) + a.shape[2:])
    perm = (1, 0, 3, 2) + tuple(range(4, a.ndim))
    return a.transpose(perm)


def mlstm_chunkwise(q, k, v, i_pre, f_pre, norm_g):
    B, S = q.shape[0], q.shape[1]
    nc = S // M_CHUNK
    f32 = jnp.float32
    qc = _to_chunks(q.astype(f32), nc)
    kc = _to_chunks(k.astype(f32) * (M_DQK ** -0.5), nc)
    vc = _to_chunks(v.astype(f32), nc)
    igc = _to_chunks(soft_cap(i_pre.astype(f32)), nc)
    lfc = _to_chunks(jax.nn.log_sigmoid(soft_cap(f_pre.astype(f32))), nc)
    causal = jnp.tril(jnp.ones((M_CHUNK, M_CHUNK), dtype=bool))

    def step(carry, inp):
        C, n, m = carry
        qx, kx, vx, ig, lf = inp
        b = jnp.cumsum(lf, axis=-1)
        inter = b + m[..., None]
        dmat = jnp.where(causal, b[..., :, None] - b[..., None, :] + ig[..., None, :], -jnp.inf)
        mt = jnp.maximum(inter, jnp.max(dmat, axis=-1))
        w = jnp.exp(dmat - mt[..., None])
        sqk = jnp.einsum('bhtd,bhsd->bhts', qx, kx) * w
        si = jnp.exp(inter - mt)
        num = si[..., None] * jnp.einsum('bhtd,bhdv->bhtv', qx, C) + jnp.einsum('bhts,bhsv->bhtv', sqk, vx)
        nq = si * jnp.einsum('bhtd,bhd->bht', qx, n) + jnp.sum(sqk, axis=-1)
        h = num / jnp.maximum(jnp.abs(nq), jnp.exp(-mt))[..., None]
        bl = b[..., -1]
        g = bl[..., None] - b + ig
        m_new = jnp.maximum(bl + m, jnp.max(g, axis=-1))
        decay = jnp.exp(bl + m - m_new)
        wg = jnp.exp(g - m_new[..., None])
        C_new = decay[..., None, None] * C + jnp.einsum('bhs,bhsd,bhsv->bhdv', wg, kx, vx)
        n_new = decay[..., None] * n + jnp.einsum('bhs,bhsd->bhd', wg, kx)
        return (C_new, n_new, m_new), h

    init = (jnp.zeros((B, M_HEADS, M_DQK, M_DV), f32), jnp.zeros((B, M_HEADS, M_DQK), f32), jnp.zeros((B, M_HEADS), f32))
    _, hs = lax.scan(step, init, (qc, kc, vc, igc, lfc))
    h = hs.transpose(1, 0, 3, 2, 4).reshape(B, S, M_HEADS, M_DV)
    h = h * lax.rsqrt(jnp.mean(jnp.square(h), axis=-1, keepdims=True) + RMS_EPS) * norm_g.astype(f32)
    return h.astype(q.dtype)


def moe_ffn(xf, w_router, b_router, w_eg, w_eu, w_ed, w_sg, w_su, w_sd):
    T, D = xf.shape
    scores = jax.nn.sigmoid((xf @ w_router).astype(jnp.float32))
    _, idx = lax.top_k(scores + b_router.astype(jnp.float32), TOP_K)
    gw = jnp.take_along_axis(scores, idx, axis=-1)
    gw = gw / jnp.sum(gw, axis=-1, keepdims=True) * ROUTED_SCALE
    e_flat = idx.reshape(-1)
    w_flat = gw.reshape(-1)
    tok_flat = jnp.arange(T * TOP_K, dtype=jnp.int32) // TOP_K
    order = jnp.argsort(e_flat)
    e_sorted = e_flat[order]
    counts = jnp.bincount(e_flat, length=N_EXPERTS)
    starts = jnp.cumsum(counts) - counts
    padded = (counts + MOE_BLOCK - 1) // MOE_BLOCK * MOE_BLOCK
    ends = jnp.cumsum(padded)
    pstarts = ends - padded
    dest = pstarts[e_sorted] + (jnp.arange(T * TOP_K) - starts[e_sorted])
    n_blocks = -(-(T * TOP_K) // MOE_BLOCK) + N_EXPERTS
    n_rows = n_blocks * MOE_BLOCK
    row_tok = jnp.full((n_rows,), T, dtype=jnp.int32).at[dest].set(tok_flat[order])
    row_w = jnp.zeros((n_rows,), jnp.float32).at[dest].set(w_flat[order])
    block_e = jnp.minimum(jnp.searchsorted(ends, jnp.arange(n_blocks) * MOE_BLOCK, side='right'), N_EXPERTS - 1)
    x_pad = jnp.concatenate([xf, jnp.zeros((1, D), xf.dtype)], axis=0)

    def body(acc, blk):
        toks, wts, e = blk
        xb = x_pad[toks]
        hb = jax.nn.silu(xb @ w_eg[e]) * (xb @ w_eu[e])
        yb = (hb @ w_ed[e]).astype(jnp.float32) * wts[:, None]
        return acc.at[toks].add(yb), None

    acc0 = jnp.zeros((T + 1, D), jnp.float32)
    acc, _ = lax.scan(body, acc0, (row_tok.reshape(n_blocks, MOE_BLOCK), row_w.reshape(n_blocks, MOE_BLOCK), block_e))
    shared = (jax.nn.silu(xf @ w_sg) * (xf @ w_su)) @ w_sd
    return (acc[:T] + shared.astype(jnp.float32)).astype(xf.dtype)


def hybrid_layer(x, p_i, w_in, sinks, b_i, b_f, norm_g, w_ba, w_bm, w_out, ln_mix_g, ln_mix_b,
                 w_router, b_router, w_eg, w_eu, w_ed, w_sg, w_su, w_sd, ln_ffn_g, ln_ffn_b,
                 w_pp, w_pg, ln_ple_g, ln_ple_b):
    B, S, D = x.shape
    proj = x @ w_in
    splits = np.cumsum(IN_SIZES)[:-1].tolist()
    aq, ak, av, mq, mk, mv, mo, mi, mf, ga, gb = jnp.split(proj, splits, axis=-1)
    attn = swa_sink_attention(aq.reshape(B, S, N_HEADS, HEAD_DIM), ak.reshape(B, S, N_KV_HEADS, HEAD_DIM),
                              av.reshape(B, S, N_KV_HEADS, HEAD_DIM), sinks)
    mh = mlstm_chunkwise(mq.reshape(B, S, M_HEADS, M_DQK), mk.reshape(B, S, M_HEADS, M_DQK),
                         mv.reshape(B, S, M_HEADS, M_DV), mi + b_i, mf + b_f, norm_g)
    mh = (mh * jax.nn.sigmoid(mo).reshape(B, S, M_HEADS, M_DV)).reshape(B, S, M_V_W)
    merged = jax.nn.sigmoid(ga) * (attn @ w_ba) + jax.nn.sigmoid(gb) * (mh @ w_bm)
    x = layer_norm(DEEPNORM_ALPHA * x + merged @ w_out, ln_mix_g, ln_mix_b)
    ffn = moe_ffn(x.reshape(B * S, D), w_router, b_router, w_eg, w_eu, w_ed, w_sg, w_su, w_sd).reshape(B, S, D)
    x = layer_norm(DEEPNORM_ALPHA * x + ffn, ln_ffn_g, ln_ffn_b)
    ple = (p_i @ w_pp) * jax.nn.sigmoid(x @ w_pg)
    x = layer_norm(DEEPNORM_ALPHA * x + ple, ln_ple_g, ln_ple_b)
    return x


def setup_inputs(seed: int = 0) -> dict:
    key = jax.random.key(seed)
    ks = jax.random.split(key, 32)
    f32 = jnp.float32

    def nrm(k, shape, scale):
        return jax.random.normal(k, shape, f32) * scale

    L, D, E = DEPTH, D_MODEL, N_EXPERTS
    return {
        'x': nrm(ks[0], (BATCH, SEQ, D), 1.0),
        'p': nrm(ks[1], (DEPTH, BATCH, SEQ, PLE_DIM), 1.0),
        'ln_in_g': 1.0 + nrm(ks[2], (D,), 0.02),
        'ln_in_b': nrm(ks[3], (D,), 0.02),
        'w_in': nrm(ks[4], (L, D, IN_COLS), D ** -0.5),
        'attn_sinks': nrm(ks[5], (L, N_HEADS), 1.0),
        'mlstm_b_i': nrm(ks[6], (L, M_HEADS), 0.1),
        'mlstm_b_f': 3.0 + nrm(ks[7], (L, M_HEADS), 0.5),
        'mlstm_norm_g': 1.0 + nrm(ks[8], (L, M_HEADS, M_DV), 0.02),
        'w_branch_attn': nrm(ks[9], (L, ATTN_Q_W, D), ATTN_Q_W ** -0.5),
        'w_branch_mlstm': nrm(ks[10], (L, M_V_W, D), M_V_W ** -0.5),
        'w_out': nrm(ks[11], (L, D, D), D ** -0.5 * DEEPNORM_BETA),
        'ln_mix_g': 1.0 + nrm(ks[12], (L, D), 0.02),
        'ln_mix_b': nrm(ks[13], (L, D), 0.02),
        'w_router': nrm(ks[14], (L, D, E), D ** -0.5),
        'b_router': nrm(ks[15], (L, E), 0.01),
        'w_exp_gate': nrm(ks[16], (L, E, D, D_EXPERT), D ** -0.5),
        'w_exp_up': nrm(ks[17], (L, E, D, D_EXPERT), D ** -0.5),
        'w_exp_down': nrm(ks[18], (L, E, D_EXPERT, D), D_EXPERT ** -0.5 * DEEPNORM_BETA),
        'w_sh_gate': nrm(ks[19], (L, D, D_SHARED), D ** -0.5),
        'w_sh_up': nrm(ks[20], (L, D, D_SHARED), D ** -0.5),
        'w_sh_down': nrm(ks[21], (L, D_SHARED, D), D_SHARED ** -0.5 * DEEPNORM_BETA),
        'ln_ffn_g': 1.0 + nrm(ks[22], (L, D), 0.02),
        'ln_ffn_b': nrm(ks[23], (L, D), 0.02),
        'w_ple_proj': nrm(ks[24], (L, PLE_DIM, D), PLE_DIM ** -0.5 * DEEPNORM_BETA),
        'w_ple_gate': nrm(ks[25], (L, D, D), D ** -0.5),
        'ln_ple_g': 1.0 + nrm(ks[26], (L, D), 0.02),
        'ln_ple_b': nrm(ks[27], (L, D), 0.02),
    }


def reference(x, p, ln_in_g, ln_in_b, w_in, attn_sinks, mlstm_b_i, mlstm_b_f, mlstm_norm_g,
              w_branch_attn, w_branch_mlstm, w_out, ln_mix_g, ln_mix_b, w_router, b_router,
              w_exp_gate, w_exp_up, w_exp_down, w_sh_gate, w_sh_up, w_sh_down, ln_ffn_g, ln_ffn_b,
              w_ple_proj, w_ple_gate, ln_ple_g, ln_ple_b):
    h = layer_norm(x, ln_in_g, ln_in_b)
    for i in range(DEPTH):
        h = hybrid_layer(h, p[i], w_in[i], attn_sinks[i], mlstm_b_i[i], mlstm_b_f[i], mlstm_norm_g[i],
                         w_branch_attn[i], w_branch_mlstm[i], w_out[i], ln_mix_g[i], ln_mix_b[i],
                         w_router[i], b_router[i], w_exp_gate[i], w_exp_up[i], w_exp_down[i],
                         w_sh_gate[i], w_sh_up[i], w_sh_down[i], ln_ffn_g[i], ln_ffn_b[i],
                         w_ple_proj[i], w_ple_gate[i], ln_ple_g[i], ln_ple_b[i])
    return h
```

```cpp
#include <hip/hip_runtime.h>
#ifndef FP8_P1
#define FP8_P1 1
#endif
#ifndef FP8_P6
#define FP8_P6 1
#endif
#ifndef FP8_P14
#define FP8_P14 1
#endif
#include <cstdio>
#include <cstdint>
#include <type_traits>

#define GAS __attribute__((address_space(1)))
#define LAS __attribute__((address_space(3)))
typedef unsigned short bf16;
typedef unsigned v4u __attribute__((ext_vector_type(4)));
typedef unsigned v2u __attribute__((ext_vector_type(2)));
typedef float f32x4 __attribute__((ext_vector_type(4)));
typedef float f32x2 __attribute__((ext_vector_type(2)));
typedef short bf16x8 __attribute__((ext_vector_type(8)));
typedef short bf16x4 __attribute__((ext_vector_type(4)));

constexpr int T = 32768, D = 2048, SEQ = 16384;
constexpr int NPROJ = 8448;
constexpr int C_Q = 0, C_K = 1024, C_V = 1152, C_MQ = 1280, C_MK = 1792, C_MV = 2304, C_MO = 3328, C_GA = 4352, C_GB = 6400;
constexpr int WIN_LD = 8456;
#define PSEG(P, C) ((P) + (size_t)T * (C))
constexpr int NEXP = 64, TOPK = 8, DE = 512;
constexpr int MAXTILES = (T * TOPK) / 256 + NEXP + T / 256;
constexpr float LOG2E = 1.4426950408889634f;
constexpr float ALPHA = 1.189207115002721f;
constexpr float LN_EPS = 1e-5f, RMS_EPS = 1e-6f;

constexpr size_t MiB = 1u << 20;
constexpr size_t WS_CTL = 0, CTL_ZERO_BYTES = 1 * MiB;
constexpr size_t WS_GIF = 1 * MiB;
constexpr size_t WS_SC = 2 * MiB;
constexpr size_t WS_MS = 2 * MiB + 256 * 1024;
constexpr size_t WS_DN = 3 * MiB;
constexpr size_t WS_NST = 4 * MiB;
constexpr size_t WS_IDX = 5 * MiB;
constexpr size_t WS_GW = 6 * MiB;
constexpr size_t WS_RK = 7 * MiB;
constexpr size_t WS_TOKSLOT = 8 * MiB;
constexpr size_t WS_HIST = 9 * MiB;
constexpr size_t WS_META = 9 * MiB + 256 * 1024;
constexpr size_t WS_TILEE = 9 * MiB + 512 * 1024;
constexpr size_t WS_ROWTOK = 10 * MiB;
constexpr size_t WS_ROWW = 11 * MiB;
constexpr size_t WS_WIN = 16 * MiB;
constexpr size_t WS_WBA = 49 * MiB;
constexpr size_t WS_WBM = 53 * MiB;
constexpr size_t WS_WOUT = 57 * MiB;
constexpr size_t WS_WR = 65 * MiB;
constexpr size_t WS_WPP = 66 * MiB;
constexpr size_t WS_WPG = 67 * MiB;
constexpr size_t WS_PB = 75 * MiB;
constexpr size_t WS_H = 92 * MiB;
constexpr size_t WS_MG = 220 * MiB;
constexpr size_t WS_PROJ = 348 * MiB;
constexpr size_t WS_DC = 876 * MiB;
constexpr size_t WS_X8 = 348 * MiB;
constexpr size_t WS_HB = 412 * MiB;
constexpr size_t WS_PPB = 412 * MiB;
constexpr size_t WS_Y = 564 * MiB;
constexpr size_t WS_WGU = 876 * MiB;
constexpr size_t WS_WD = 1006 * MiB;
constexpr size_t WS_LNX = 1136 * MiB;
constexpr size_t WS_LNX2 = 1144 * MiB;
constexpr size_t WS_END = 1152 * MiB;
constexpr float W8_SCALE = 64.0f, HB8_SCALE = 4.0f, Y8_SCALE = 16.0f, MG8_SCALE = 8.0f;
constexpr size_t WS_H8 = 1004 * MiB;

constexpr int CW_TMO = 0;
constexpr int CW_BAR = 4096;
constexpr int CW_LN2 = 65536 + 32768;
constexpr int CW_LN = 65536;

constexpr int RING_OFF = 0, RING_BYTES = 131072;
constexpr int TOKTAB_OFF = RING_BYTES;
constexpr int ETAB_OFF = TOKTAB_OFF + 10240;
constexpr int LDSCTL_OFF = ETAB_OFF + 256, MISC_OFF = LDSCTL_OFF + 64;
constexpr int LDS_BYTES = 147456;
static_assert(MISC_OFF + 128 <= LDS_BYTES, "LDS map");

#define RLX_AGENT __ATOMIC_RELAXED, __HIP_MEMORY_SCOPE_AGENT
#define LDS_WAIT() asm volatile("s_waitcnt lgkmcnt(0)" ::: "memory")
#define VM_WAIT() asm volatile("s_waitcnt vmcnt(0)" ::: "memory")
#define LBAR() do { asm volatile("s_waitcnt lgkmcnt(0)" ::: "memory"); __builtin_amdgcn_s_barrier(); asm volatile("" ::: "memory"); } while (0)

__device__ __forceinline__ float bflo(unsigned u) { return __uint_as_float(u << 16); }
__device__ __forceinline__ float bfhi(unsigned u) { return __uint_as_float(u & 0xffff0000u); }
__device__ __forceinline__ float bf2f(unsigned short b) { return __uint_as_float(((unsigned)b) << 16); }
typedef __bf16 bf16x2_t __attribute__((ext_vector_type(2)));
__device__ __forceinline__ unsigned pk2(float lo, float hi) { f32x2 f = {lo, hi}; return __builtin_bit_cast(unsigned, __builtin_convertvector(f, bf16x2_t)); }
__device__ __forceinline__ unsigned f2bf(float f) { return pk2(f, 0.f) & 0xffffu; }
typedef int v8i __attribute__((ext_vector_type(8)));
typedef int v4i __attribute__((ext_vector_type(4)));
__device__ __forceinline__ float clamp8(float x) { return __builtin_amdgcn_fmed3f(x, -448.0f, 448.0f); }
__device__ __forceinline__ unsigned pk4_fp8(float a, float b, float c, float d) {
    unsigned r = (unsigned)__builtin_amdgcn_cvt_pk_fp8_f32(clamp8(a), clamp8(b), 0, false); return (unsigned)__builtin_amdgcn_cvt_pk_fp8_f32(clamp8(c), clamp8(d), (int)r, true); }
__device__ __forceinline__ float fast_exp2(float x) { return __builtin_amdgcn_exp2f(x); }
__device__ __forceinline__ float fast_rcp(float x) { return __builtin_amdgcn_rcpf(x); }
__device__ __forceinline__ float sigmoidf_(float v) { return fast_rcp(1.0f + fast_exp2(-v * LOG2E)); }
__device__ __forceinline__ float wave_sum(float v) {
#pragma unroll
    for (int o = 1; o < 64; o <<= 1) v += __shfl_xor(v, o);
    return v;
}
__device__ __forceinline__ float wave_max(float v) {
#pragma unroll
    for (int o = 1; o < 64; o <<= 1) v = fmaxf(v, __shfl_xor(v, o));
    return v;
}

__device__ __forceinline__ f32x4 zero_acc() { f32x4 z = (f32x4){0.f, 0.f, 0.f, 0.f}; asm volatile("" : "+v"(z)); return z; }
namespace pg8 {
template <class T, class = void> struct after_drain : std::false_type {};
template <class T> struct after_drain<T, std::void_t<decltype(T::AFTER_DRAIN)>> : std::bool_constant<T::AFTER_DRAIN> {};
constexpr int BM = 256, BK = 64, HALF = 128, HTB = HALF * BK * 2, STAGE_BYTES = 8 * HTB;
__host__ __device__ __forceinline__ int lds_byte(int r, int c) { const int st = (r >> 4) * 2 + (c >> 5), rr = r & 15, cc = c & 31, ob = rr * 64 + cc * 2; return st * 1024 + (ob ^ (((ob >> 9) & 1) << 5)); }
__host__ __device__ __forceinline__ void stage_rc(int b, int& R, int& C) { const int st = b / 1024, sb = b % 1024, swz = sb ^ (((sb >> 9) & 1) << 5); R = (st >> 1) * 16 + swz / 64; C = (st & 1) * 32 + (swz % 64) / 2; }
__host__ __device__ __forceinline__ int perm32(int rho) { const int n = rho >> 4, i = rho & 15; return 8 * (i >> 2) + 4 * n + (i & 3); }

struct UnitD { const char* A; const char* B; int pm, pn, aux, slot; };

struct DenseOrder {
    int nM, nN, nwg, G, c;
    __device__ void init(int nM_, int nN_, int G_, int c_) { nM = nM_; nN = nN_; nwg = nM * nN; G = G_; c = c_; }
    __device__ __forceinline__ bool tile(int i, int& pm, int& pn) const {
        const long L = (long)i * G + c; if (L >= nwg) return false;
        int wgid = (int)L; { const int q = nwg / 8, r = nwg % 8, xcd = wgid % 8, off = wgid / 8; wgid = (xcd < r ? xcd * (q + 1) : r * (q + 1) + (xcd - r) * q) + off; }
        const int nig = 8 * nN, gid = wgid / nig, fm = gid * 8, gsz = (nM - fm) < 8 ? (nM - fm) : 8;
        pm = fm + ((wgid % nig) % gsz); pn = (wgid % nig) / gsz; return true;
    }
};

template <class Epi, class Sched, bool GATHER, bool ALIGN_EPI, bool FP8 = false>
__device__ __forceinline__ void gemm_phase(LAS unsigned char* lds, const int lda2, const int ldb2, const int nt, const Sched& S, const Epi& E, LAS const unsigned short* tab, const int scl_e8 = 127) {
    const int sclv = scl_e8 * 0x01010101;
    int tid_ = threadIdx.x; asm volatile("" : "+v"(tid_));
    const int tid = tid_, wid = __builtin_amdgcn_readfirstlane(tid >> 6), lane = tid & 63, wr = wid >> 2, wc = wid & 3, fr = lane & 15, fq = lane >> 4;
    int Ri[2], Ci[2]; unsigned voffB[2];
#pragma unroll
    for (int i = 0; i < 2; ++i) { int R, C; stage_rc(tid * 16 + i * 8192, R, C); Ri[i] = R; Ci[i] = C; const int Rb = (R & ~31) + perm32(R & 31); voffB[i] = (unsigned)(Rb * ldb2 + C * 2); }
    const size_t kstep = (size_t)(BK * 2);
    const size_t hstepB = (size_t)HALF * ldb2;
    const unsigned ldsw = (unsigned)wid * 1024u;
    const int aoff = lds_byte(wr * 64 + fr, fq * 8), boff = lds_byte(wc * 32 + fr, fq * 8);
#define PG8_SA(b, h) (((b) * 2 + (h)) * HTB)
#define PG8_SB(b, h) ((4 + (b) * 2 + (h)) * HTB)
#define PG8_STAGE2(bufoff, gbase, o0, o1) do { \
        __builtin_amdgcn_global_load_lds((const unsigned*)((const char*)(gbase) + (o0)), (LAS unsigned*)(lds + (bufoff) + ldsw), 16, 0, 0); \
        __builtin_amdgcn_global_load_lds((const unsigned*)((const char*)(gbase) + (o1)), (LAS unsigned*)(lds + (bufoff) + ldsw + 8192), 16, 0, 0); } while (0)
#define PG8_STAGEB(bufoff, gbase) PG8_STAGE2(bufoff, gbase, voffB[0], voffB[1])
#define PG8_RD(dst, ad, off) asm volatile("ds_read_b128 %0, %1 offset:%2" : "+v"(dst) : "v"(ad), "n"(off))
#define PG8_LDA(dst, b, h) do { if constexpr (FP8) { const unsigned ad_ = lbase + (unsigned)(PG8_SA(b, h) + aoff); _Pragma("unroll") for (int m = 0; m < 4; ++m) { PG8_RD(dst##lo[m], ad_, m * 2048); PG8_RD(dst##hi[m], ad_, m * 2048 + 1024); } } \
        else { _Pragma("unroll") for (int m = 0; m < 4; ++m) _Pragma("unroll") for (int k = 0; k < 2; ++k) dst[m][k] = *(const LAS bf16x8*)(lds + PG8_SA(b, h) + aoff + m * 2048 + k * 1024); } } while (0)
#define PG8_LDB(dst, b, h) do { if constexpr (FP8) { const unsigned ad_ = lbase + (unsigned)(PG8_SB(b, h) + boff); _Pragma("unroll") for (int n = 0; n < 2; ++n) { PG8_RD(dst##lo[n], ad_, n * 2048); PG8_RD(dst##hi[n], ad_, n * 2048 + 1024); } } \
        else { _Pragma("unroll") for (int n = 0; n < 2; ++n) _Pragma("unroll") for (int k = 0; k < 2; ++k) dst[n][k] = *(const LAS bf16x8*)(lds + PG8_SB(b, h) + boff + n * 2048 + k * 1024); } } while (0)
#define PG8_CAT(x0, x1) __builtin_shufflevector(__builtin_bit_cast(v4i, x0), __builtin_bit_cast(v4i, x1), 0, 1, 2, 3, 4, 5, 6, 7)
#define PG8_MMA(ai, bj, At, Bt) do { __builtin_amdgcn_s_setprio(1); _Pragma("unroll") for (int m = 0; m < 4; ++m) _Pragma("unroll") for (int n = 0; n < 2; ++n) { \
        if constexpr (FP8) acc[ai][bj][m][n] = __builtin_amdgcn_mfma_scale_f32_16x16x128_f8f6f4(PG8_CAT(Bt##lo[n], Bt##hi[n]), PG8_CAT(At##lo[m], At##hi[m]), acc[ai][bj][m][n], 0, 0, 0, 0x7f7f7f7f, 0, sclv); \
        else { _Pragma("unroll") for (int k = 0; k < 2; ++k) acc[ai][bj][m][n] = __builtin_amdgcn_mfma_f32_16x16x32_bf16(Bt[n][k], At[m][k], acc[ai][bj][m][n], 0, 0, 0); } } \
        __builtin_amdgcn_s_setprio(0); } while (0)
#define PG8_WAIT_V(n) asm volatile("s_waitcnt vmcnt(" #n ")" ::: "memory")
#define PG8_WAIT_L(n) asm volatile("s_waitcnt lgkmcnt(" #n ")" ::: "memory")
#define PG8_BAR __builtin_amdgcn_s_barrier()
#define PG8_SCHED __builtin_amdgcn_sched_barrier(0)
#define PG8_SETA(dst, u) do { _Pragma("unroll") for (int h = 0; h < 2; ++h) _Pragma("unroll") for (int i = 0; i < 2; ++i) { \
        if (GATHER) { const unsigned tok = tab[(u).slot * 256 + h * 128 + Ri[i]]; dst[h][i] = tok * (unsigned)lda2 + (unsigned)(Ci[i] * 2); } \
        else dst[h][i] = (unsigned)((h * 128 + Ri[i]) * lda2 + Ci[i] * 2); } } while (0)
    UnitD cur, nxt; int ui = 0;
    if (!S.get(0, cur)) return;
    unsigned cv[2][2], nv[2][2];
    PG8_SETA(cv, cur);
    f32x4 acc[2][2][4][2];
#pragma unroll
    for (int a = 0; a < 2; ++a)
#pragma unroll
        for (int b = 0; b < 2; ++b)
#pragma unroll
            for (int m = 0; m < 4; ++m)
#pragma unroll
                for (int n = 0; n < 2; ++n) acc[a][b][m][n] = (f32x4){0.f, 0.f, 0.f, 0.f};
    bf16x8 At[4][2], B0[2][2], B1[2][2];
    v4i Atlo[4], Athi[4], B0lo[2], B0hi[2], B1lo[2], B1hi[2];
    if constexpr (FP8) { _Pragma("unroll") for (int m = 0; m < 4; ++m) { Atlo[m] = (v4i){0, 0, 0, 0}; Athi[m] = (v4i){0, 0, 0, 0}; } _Pragma("unroll") for (int n = 0; n < 2; ++n) { B0lo[n] = B0hi[n] = B1lo[n] = B1hi[n] = (v4i){0, 0, 0, 0}; } }
    const unsigned lbase = (unsigned)(size_t)lds;
    const char* cA = cur.A; const char* cB = cur.B;
    PG8_STAGEB(PG8_SB(0, 0), cB); PG8_STAGEB(PG8_SB(0, 1), cB + hstepB); PG8_STAGE2(PG8_SA(0, 0), cA, cv[0][0], cv[0][1]); PG8_STAGE2(PG8_SA(0, 1), cA, cv[1][0], cv[1][1]);
    if (wr == 1) PG8_BAR;
    PG8_WAIT_V(2); PG8_BAR;
    PG8_STAGEB(PG8_SB(1, 0), cB + kstep); PG8_STAGE2(PG8_SA(1, 0), cA + kstep, cv[0][0], cv[0][1]); PG8_STAGEB(PG8_SB(1, 1), cB + hstepB + kstep);
    PG8_WAIT_V(6); PG8_BAR;
    for (;;) {
        const bool has_next = S.get(ui + 1, nxt);
        const char* nA = has_next ? nxt.A : cA; const char* nB = has_next ? nxt.B : cB;
        if (GATHER) { if (has_next) PG8_SETA(nv, nxt); else { nv[0][0] = cv[0][0]; nv[0][1] = cv[0][1]; nv[1][0] = cv[1][0]; nv[1][1] = cv[1][1]; } }
        else { nv[0][0] = cv[0][0]; nv[0][1] = cv[0][1]; nv[1][0] = cv[1][0]; nv[1][1] = cv[1][1]; }
        for (int t = 0; t < nt; t += 2) {
            const bool last = (t == nt - 2);
            const char* a1 = cA + (size_t)(t + 1) * kstep;
            const char* a2 = last ? nA : cA + (size_t)(t + 2) * kstep; const char* b2 = last ? nB : cB + (size_t)(t + 2) * kstep;
            const char* a3 = a2 + kstep; const char* b3 = b2 + kstep;
            const unsigned x00 = last ? nv[0][0] : cv[0][0], x01 = last ? nv[0][1] : cv[0][1], x10 = last ? nv[1][0] : cv[1][0], x11 = last ? nv[1][1] : cv[1][1];
            PG8_LDB(B0, 0, 0); PG8_LDB(B1, 0, 1); PG8_SCHED; PG8_LDA(At, 0, 0); PG8_STAGE2(PG8_SA(1, 1), a1, cv[1][0], cv[1][1]);
            PG8_WAIT_V(8); PG8_WAIT_L(0); PG8_BAR; PG8_MMA(0, 0, At, B0); PG8_MMA(0, 1, At, B1); PG8_BAR; PG8_SCHED;
            PG8_LDA(At, 0, 1); PG8_STAGEB(PG8_SB(0, 0), b2); PG8_STAGEB(PG8_SB(0, 1), b2 + hstepB); PG8_STAGE2(PG8_SA(0, 0), a2, x00, x01);
            PG8_WAIT_V(8); PG8_WAIT_L(0); PG8_BAR; PG8_MMA(1, 0, At, B0); PG8_MMA(1, 1, At, B1); PG8_BAR; PG8_SCHED;
            PG8_LDB(B0, 1, 0); PG8_LDB(B1, 1, 1); PG8_SCHED; PG8_LDA(At, 1, 0); PG8_STAGE2(PG8_SA(0, 1), a2, x10, x11);
            PG8_WAIT_V(8); PG8_WAIT_L(0); PG8_BAR; PG8_MMA(0, 0, At, B0); PG8_MMA(0, 1, At, B1); PG8_BAR; PG8_SCHED;
            PG8_LDA(At, 1, 1); PG8_STAGEB(PG8_SB(1, 0), b3); PG8_STAGEB(PG8_SB(1, 1), b3 + hstepB); PG8_STAGE2(PG8_SA(1, 0), a3, x00, x01);
            PG8_WAIT_V(8); PG8_WAIT_L(0); PG8_BAR; PG8_MMA(1, 0, At, B0); PG8_MMA(1, 1, At, B1); PG8_BAR; PG8_SCHED;
        }
        if constexpr (ALIGN_EPI) { if (wr == 0) PG8_BAR; }
        bool zero = true;
        if constexpr (!after_drain<Epi>::value) zero = E(acc, cur, wr, wc, fr, fq);
        if (!has_next) break;
        if (zero) {
#pragma unroll
            for (int a = 0; a < 2; ++a)
#pragma unroll
                for (int b = 0; b < 2; ++b)
#pragma unroll
                    for (int m = 0; m < 4; ++m)
#pragma unroll
                        for (int n = 0; n < 2; ++n) acc[a][b][m][n] = (f32x4){0.f, 0.f, 0.f, 0.f};
        }
        cur = nxt; cA = nA; cB = nB; ++ui;
        cv[0][0] = nv[0][0]; cv[0][1] = nv[0][1]; cv[1][0] = nv[1][0]; cv[1][1] = nv[1][1];
        if constexpr (ALIGN_EPI) { if (wr == 1) PG8_BAR; }
    }
    PG8_WAIT_V(0);
    if constexpr (!ALIGN_EPI) { if (wr == 0) PG8_BAR; }
    PG8_BAR;
    if constexpr (after_drain<Epi>::value) E.fused(acc, cur, wr, wc, fr, fq, lds);
#undef PG8_SA
#undef PG8_SB
#undef PG8_STAGE2
#undef PG8_STAGEB
#undef PG8_LDA
#undef PG8_RD
#undef PG8_LDB
#undef PG8_MMA
#undef PG8_CAT
#undef PG8_WAIT_V
#undef PG8_WAIT_L
#undef PG8_BAR
#undef PG8_SCHED
#undef PG8_SETA
}
}

using pg8::UnitD;
#define EPI_LOOP_BEGIN _Pragma("unroll") for (int ai = 0; ai < 2; ++ai) _Pragma("unroll") for (int m = 0; m < 4; ++m) { const int row = u.pm * 256 + ai * 128 + wr * 64 + m * 16 + fr; _Pragma("unroll") for (int bj = 0; bj < 2; ++bj) { const int col8 = bj * 128 + wc * 32 + 8 * fq; f32x4 v0 = acc[ai][bj][m][0], v1 = acc[ai][bj][m][1];
#define EPI_LOOP_END } }
__device__ __forceinline__ v4u pack8(f32x4 v0, f32x4 v1) { v4u w; w.x = pk2(v0[0], v0[1]); w.y = pk2(v0[2], v0[3]); w.z = pk2(v1[0], v1[1]); w.w = pk2(v1[2], v1[3]); return w; }
__device__ __forceinline__ void unpack8(v4u w, f32x4& a, f32x4& b) { a = (f32x4){bflo(w.x), bfhi(w.x), bflo(w.y), bfhi(w.y)}; b = (f32x4){bflo(w.z), bfhi(w.z), bflo(w.w), bfhi(w.w)}; }

struct EpiProj {
    bf16* O;
    __device__ __forceinline__ bool operator()(f32x4 (&acc)[2][2][4][2], const UnitD& u, int wr, int wc, int fr, int fq) const {
        const int pn = u.pn;
        const float sc = ((pn < 4) ? (0.125f * LOG2E) : ((pn == 7 || pn == 8) ? 0.08838834764831845f : 1.0f));
        const bool sig = pn >= 13;
        EPI_LOOP_BEGIN
            v0 = v0 * sc; v1 = v1 * sc;
            if (sig) {
#pragma unroll
                for (int j = 0; j < 4; ++j) { v0[j] = sigmoidf_(v0[j]); v1[j] = sigmoidf_(v1[j]); }
            }
            { const int g0 = pn * 256 + bj * 128; int C, W;
              if (g0 < C_K) { C = C_Q; W = 1024; } else if (g0 < C_V) { C = C_K; W = 128; } else if (g0 < C_MQ) { C = C_V; W = 128; } else if (g0 < C_MK) { C = C_MQ; W = 512; } else if (g0 < C_MV) { C = C_MK; W = 512; }
              else if (g0 < C_MO) { C = C_MV; W = 1024; } else if (g0 < C_GA) { C = C_MO; W = 1024; } else if (g0 < C_GB) { C = C_GA; W = 2048; } else { C = C_GB; W = 2048; }
              *(v4u*)(PSEG(O, C) + (size_t)row * W + (pn * 256 + col8 - C)) = pack8(v0, v1); }
        EPI_LOOP_END
        return true;
    }
};
struct EpiMerge {
    const bf16* P; bf16* O;
    __device__ __forceinline__ bool operator()(f32x4 (&acc)[2][2][4][2], const UnitD& u, int wr, int wc, int fr, int fq) const {
        if (u.aux == 0) {
#pragma unroll
            for (int ai = 0; ai < 2; ++ai) {
                v4u gav[4][2], gbw[4][2];
#pragma unroll
                for (int m = 0; m < 4; ++m)
#pragma unroll
                    for (int bj = 0; bj < 2; ++bj) { const size_t o = (size_t)(u.pm * 256 + ai * 128 + wr * 64 + m * 16 + fr) * 2048 + u.pn * 256 + bj * 128 + wc * 32 + 8 * fq; gav[m][bj] = __builtin_nontemporal_load((const v4u*)(PSEG(P, C_GA) + o)); gbw[m][bj] = *(const v4u*)(PSEG(P, C_GB) + o); }
#pragma unroll
                for (int m = 0; m < 4; ++m)
#pragma unroll
                    for (int bj = 0; bj < 2; ++bj) {
                        f32x4 v0 = acc[ai][bj][m][0], v1 = acc[ai][bj][m][1];
                        f32x4 a0, a1, b0, b1; unpack8(gav[m][bj], a0, a1); unpack8(gbw[m][bj], b0, b1);
#pragma unroll
                        for (int j = 0; j < 4; ++j) { v0[j] = v0[j] * a0[j] * fast_rcp(b0[j]); v1[j] = v1[j] * a1[j] * fast_rcp(b1[j]); }
                        acc[ai][bj][m][0] = v0; acc[ai][bj][m][1] = v1;
                    }
            }
            return false;
        } else {
            v4u gbv2[2][4][2];
#pragma unroll
            for (int ai = 0; ai < 2; ++ai)
#pragma unroll
                for (int m = 0; m < 4; ++m)
#pragma unroll
                    for (int bj = 0; bj < 2; ++bj) gbv2[ai][m][bj] = __builtin_nontemporal_load((const v4u*)(PSEG(P, C_GB) + (size_t)(u.pm * 256 + ai * 128 + wr * 64 + m * 16 + fr) * 2048 + u.pn * 256 + bj * 128 + wc * 32 + 8 * fq));
#pragma unroll
            for (int ai = 0; ai < 2; ++ai) {
                const v4u (&gbv)[4][2] = gbv2[ai];
#pragma unroll
                for (int m = 0; m < 4; ++m)
#pragma unroll
                    for (int bj = 0; bj < 2; ++bj) {
                        const int row = u.pm * 256 + ai * 128 + wr * 64 + m * 16 + fr, col8 = bj * 128 + wc * 32 + 8 * fq;
                        f32x4 v0 = acc[ai][bj][m][0], v1 = acc[ai][bj][m][1];
                        f32x4 b0, b1; unpack8(gbv[m][bj], b0, b1);
                        v0 = v0 * b0; v1 = v1 * b1;
                        if (FP8_P6) { v2u o8; o8.x = pk4_fp8(v0[0] * MG8_SCALE, v0[1] * MG8_SCALE, v0[2] * MG8_SCALE, v0[3] * MG8_SCALE); o8.y = pk4_fp8(v1[0] * MG8_SCALE, v1[1] * MG8_SCALE, v1[2] * MG8_SCALE, v1[3] * MG8_SCALE);
                            *(v2u*)((unsigned char*)O + (size_t)row * D + u.pn * 256 + col8) = o8; }
                        else *(v4u*)(O + (size_t)row * D + u.pn * 256 + col8) = pack8(v0, v1);
                    }
            }
            return true;
        }
    }
};
struct EpiResid {
    bf16* H; float scale;
    __device__ __forceinline__ bool operator()(f32x4 (&acc)[2][2][4][2], const UnitD& u, int wr, int wc, int fr, int fq) const {
        EPI_LOOP_BEGIN
            bf16* p = H + (size_t)row * D + u.pn * 256 + col8;
            const v4u hv = *(const v4u*)p; f32x4 h0, h1; unpack8(hv, h0, h1);
            v0 = v0 * scale + h0 * ALPHA; v1 = v1 * scale + h1 * ALPHA;
            *(v4u*)p = pack8(v0, v1);
        EPI_LOOP_END
        return true;
    }
};
struct EpiGU {
    unsigned char* HB; const float* roww;
    __device__ __forceinline__ bool operator()(f32x4 (&acc)[2][2][4][2], const UnitD& u, int wr, int wc, int fr, int fq) const {
#pragma unroll
        for (int ai = 0; ai < 2; ++ai) {
            float wv[4];
#pragma unroll
            for (int m = 0; m < 4; ++m) wv[m] = roww[u.pm * 256 + ai * 128 + wr * 64 + m * 16 + fr];
#pragma unroll
            for (int m = 0; m < 4; ++m) {
                const int row = u.pm * 256 + ai * 128 + wr * 64 + m * 16 + fr;
                const float w = wv[m];
                const f32x4 g0 = acc[ai][0][m][0], u0 = acc[ai][1][m][0], g1 = acc[ai][0][m][1], u1 = acc[ai][1][m][1];
                f32x4 r0, r1; const float ws_ = w * HB8_SCALE;
#pragma unroll
                for (int j = 0; j < 4; ++j) { r0[j] = g0[j] * sigmoidf_(g0[j]) * u0[j] * ws_; r1[j] = g1[j] * sigmoidf_(g1[j]) * u1[j] * ws_; }
                v2u o; o.x = pk4_fp8(r0[0], r0[1], r0[2], r0[3]); o.y = pk4_fp8(r1[0], r1[1], r1[2], r1[3]);
                *(v2u*)(HB + (size_t)row * DE + u.pn * 128 + wc * 32 + 8 * fq) = o;
            }
        }
        return true;
    }
};
struct EpiStore {
    bf16* O; int ldo; float scale;
    __device__ __forceinline__ bool operator()(f32x4 (&acc)[2][2][4][2], const UnitD& u, int wr, int wc, int fr, int fq) const {
        EPI_LOOP_BEGIN
            v0 = v0 * scale; v1 = v1 * scale;
            *(v4u*)(O + (size_t)row * ldo + u.aux + col8) = pack8(v0, v1);
        EPI_LOOP_END
        return true;
    }
};
__device__ __forceinline__ void store_fp8_wide(unsigned char* base  , size_t ldo, const v2u (&o)[4], int fq) {
    const int odd = fq & 1;
#pragma unroll
    for (int p = 0; p < 2; ++p) {
        const auto rx = __builtin_amdgcn_permlane16_swap(o[2 * p].x, o[2 * p + 1].x, false, false);
        const auto ry = __builtin_amdgcn_permlane16_swap(o[2 * p].y, o[2 * p + 1].y, false, false);
        v4u w; w.x = rx[0]; w.y = ry[0]; w.z = rx[1]; w.w = ry[1];
        *(v4u*)(base + (size_t)((2 * p + odd) * 16) * ldo + 8 * (fq & ~1)) = w;
    }
}
__device__ __forceinline__ unsigned pk4_fp8_nc(float a, float b, float c, float d) { unsigned r = (unsigned)__builtin_amdgcn_cvt_pk_fp8_f32(a, b, 0, false); return (unsigned)__builtin_amdgcn_cvt_pk_fp8_f32(c, d, (int)r, true); }
struct EpiStore8 {
    unsigned char* O; int ldo;
    __device__ __forceinline__ bool operator()(f32x4 (&acc)[2][2][4][2], const UnitD& u, int wr, int wc, int fr, int fq) const {
#pragma unroll
        for (int ai = 0; ai < 2; ++ai)
#pragma unroll
            for (int bj = 0; bj < 2; ++bj) {
                v2u o[4];
#pragma unroll
                for (int m = 0; m < 4; ++m) { const f32x4 v0 = acc[ai][bj][m][0], v1 = acc[ai][bj][m][1]; o[m].x = pk4_fp8_nc(v0[0], v0[1], v0[2], v0[3]); o[m].y = pk4_fp8_nc(v1[0], v1[1], v1[2], v1[3]); }
                store_fp8_wide(O + (size_t)(u.pm * 256 + ai * 128 + wr * 64 + fr) * ldo + u.aux + bj * 128 + wc * 32, (size_t)ldo, o, fq);
            }
        return true;
    }
};
struct EpiPle {
    const bf16* X2; const bf16* PP; bf16* O; float scale;
    __device__ __forceinline__ bool operator()(f32x4 (&acc)[2][2][4][2], const UnitD& u, int wr, int wc, int fr, int fq) const {
        EPI_LOOP_BEGIN
            const size_t o = (size_t)row * D + u.pn * 256 + col8;
            const v4u xv = *(const v4u*)(X2 + o), pv = *(const v4u*)(PP + o);
            f32x4 x0, x1, p0, p1; unpack8(xv, x0, x1); unpack8(pv, p0, p1);
#pragma unroll
            for (int j = 0; j < 4; ++j) { v0[j] = x0[j] * ALPHA + p0[j] * sigmoidf_(v0[j] * scale); v1[j] = x1[j] * ALPHA + p1[j] * sigmoidf_(v1[j] * scale); }
            *(v4u*)(O + o) = pack8(v0, v1);
        EPI_LOOP_END
        return true;
    }
};

struct EpiPleLn {
    static constexpr bool AFTER_DRAIN = true;
    const bf16* X2; const bf16* PP; float* out; const float* ln_g; const float* ln_b; unsigned long long* xslot; unsigned* cnt;
    __device__ __forceinline__ void fused(f32x4 (&acc)[2][2][4][2], const UnitD& u, int wr, int wc, int fr, int fq, LAS unsigned char* lds) const {
        LAS f32x2* P = (LAS f32x2*)lds;
        LAS f32x2* S = (LAS f32x2*)(lds + 8192);
#pragma unroll
        for (int ai = 0; ai < 2; ++ai)
            {
                v4u xv[4][2], pv[4][2];
#pragma unroll
                for (int ml = 0; ml < 4; ++ml)
#pragma unroll
                    for (int bj = 0; bj < 2; ++bj) { const size_t o = (size_t)(u.pm * 256 + ai * 128 + wr * 64 + ml * 16 + fr) * D + u.pn * 256 + bj * 128 + wc * 32 + 8 * fq; xv[ml][bj] = __builtin_nontemporal_load((const v4u*)(X2 + o)); pv[ml][bj] = __builtin_nontemporal_load((const v4u*)(PP + o)); }
#pragma unroll
                for (int ml = 0; ml < 4; ++ml)
#pragma unroll
                    for (int bj = 0; bj < 2; ++bj) { const int m = ml;
                        f32x4 v0 = acc[ai][bj][m][0], v1 = acc[ai][bj][m][1];
                        f32x4 x0, x1, p0, p1; unpack8(xv[ml][bj], x0, x1); unpack8(pv[ml][bj], p0, p1);
#pragma unroll
                        for (int j = 0; j < 4; ++j) { v0[j] = x0[j] * ALPHA + p0[j] * sigmoidf_(v0[j]); v1[j] = x1[j] * ALPHA + p1[j] * sigmoidf_(v1[j]); }
                        acc[ai][bj][m][0] = v0; acc[ai][bj][m][1] = v1;
                        asm volatile("" : "+v"(acc[ai][bj][m][0]), "+v"(acc[ai][bj][m][1]) :: "memory");
                    }
            }
#pragma unroll
        for (int ai = 0; ai < 2; ++ai)
#pragma unroll
            for (int m = 0; m < 4; ++m) {
                float sm = 0.f, sq = 0.f;
#pragma unroll
                for (int bj = 0; bj < 2; ++bj)
#pragma unroll
                    for (int n = 0; n < 2; ++n) { const f32x4 x = acc[ai][bj][m][n]; sm += (x[0] + x[1]) + (x[2] + x[3]); sq += (x[0] * x[0] + x[1] * x[1]) + (x[2] * x[2] + x[3] * x[3]); }
                sm += __shfl_xor(sm, 16); sm += __shfl_xor(sm, 32); sq += __shfl_xor(sq, 16); sq += __shfl_xor(sq, 32);
                if (fq == 0) P[(ai * 128 + wr * 64 + m * 16 + fr) * 4 + wc] = (f32x2){sm, sq};
            }
        LBAR();
        const int t = threadIdx.x;
        if (t < 256) { const f32x2 a = P[t * 4 + 0], b = P[t * 4 + 1], c = P[t * 4 + 2], d = P[t * 4 + 3];
            const float ts = (a[0] + b[0]) + (c[0] + d[0]), tq = (a[1] + b[1]) + (c[1] + d[1]);
            const unsigned long long pk = ((unsigned long long)__float_as_uint(tq) << 32) | (unsigned long long)__float_as_uint(ts);
            __hip_atomic_store(xslot + ((size_t)u.pm * 256 + t) * 8 + u.pn, pk, __ATOMIC_RELAXED, __HIP_MEMORY_SCOPE_AGENT); }
        asm volatile("s_waitcnt vmcnt(0)" ::: "memory");
        __syncthreads();
        unsigned* pc = cnt + (size_t)u.pm * 64;
        if (t == 0) {
            (void)__hip_atomic_fetch_add(pc, 1u, __ATOMIC_RELAXED, __HIP_MEMORY_SCOPE_AGENT);
            unsigned polls = 0;
            while (__hip_atomic_load(pc, __ATOMIC_RELAXED, __HIP_MEMORY_SCOPE_AGENT) < 8u) { __builtin_amdgcn_s_sleep(2); if (++polls > (1u << 22)) break; }
            __builtin_amdgcn_fence(__ATOMIC_ACQUIRE, "agent");
            asm volatile("s_waitcnt vmcnt(0)" ::: "memory");
        }
        __syncthreads();
        if (t < 256) { float ts = 0.f, tq = 0.f;
#pragma unroll
            for (int k = 0; k < 8; ++k) { const unsigned long long pk = __hip_atomic_load(xslot + ((size_t)u.pm * 256 + t) * 8 + k, __ATOMIC_RELAXED, __HIP_MEMORY_SCOPE_AGENT); ts += __uint_as_float((unsigned)pk); tq += __uint_as_float((unsigned)(pk >> 32)); }
            const float mean = ts * (1.f / D), var = fmaxf(tq * (1.f / D) - mean * mean, 0.f);
            S[t] = (f32x2){mean, rsqrtf(var + LN_EPS)}; }
        LBAR();
#pragma unroll
        for (int bj = 0; bj < 2; ++bj) {
            const int col = u.pn * 256 + bj * 128 + wc * 32 + 8 * fq;
            const f32x4 g0 = *(const f32x4*)(ln_g + col), g1 = *(const f32x4*)(ln_g + col + 4), b0 = *(const f32x4*)(ln_b + col), b1 = *(const f32x4*)(ln_b + col + 4);
#pragma unroll
            for (int ai = 0; ai < 2; ++ai)
#pragma unroll
                for (int m = 0; m < 4; ++m) {
                    const int rl = ai * 128 + wr * 64 + m * 16 + fr; const f32x2 st = S[rl];
                    const f32x4 v0 = acc[ai][bj][m][0], v1 = acc[ai][bj][m][1]; f32x4 y0, y1;
#pragma unroll
                    for (int j = 0; j < 4; ++j) { y0[j] = (v0[j] - st[0]) * st[1] * g0[j] + b0[j]; y1[j] = (v1[j] - st[0]) * st[1] * g1[j] + b1[j]; }
                    float* o = out + (size_t)(u.pm * 256 + rl) * D + col; *(f32x4*)o = y0; *(f32x4*)(o + 4) = y1;
                    asm volatile("" ::: "memory"); __builtin_amdgcn_sched_barrier(0);
                }
        }
        LBAR();
    }
};
struct EpiResidLn {
    static constexpr bool AFTER_DRAIN = true;
    bf16* H; unsigned char* X8; const float* ln_g; const float* ln_b; unsigned long long* xslot; unsigned* cnt;
    __device__ __forceinline__ void fused(f32x4 (&acc)[2][2][4][2], const UnitD& u, int wr, int wc, int fr, int fq, LAS unsigned char* lds) const {
        LAS f32x2* P = (LAS f32x2*)lds;
        LAS f32x2* S = (LAS f32x2*)(lds + 8192);
        v4u hv2[2][4][2];
#pragma unroll
        for (int ai = 0; ai < 2; ++ai)
#pragma unroll
            for (int m = 0; m < 4; ++m)
#pragma unroll
                for (int bj = 0; bj < 2; ++bj) hv2[ai][m][bj] = __builtin_nontemporal_load((const v4u*)(H + (size_t)(u.pm * 256 + ai * 128 + wr * 64 + m * 16 + fr) * D + u.pn * 256 + bj * 128 + wc * 32 + 8 * fq));
#pragma unroll
        for (int ai = 0; ai < 2; ++ai) {
            const v4u (&hv)[4][2] = hv2[ai];
#pragma unroll
            for (int m = 0; m < 4; ++m)
#pragma unroll
                for (int bj = 0; bj < 2; ++bj) {
                    f32x4 v0 = acc[ai][bj][m][0], v1 = acc[ai][bj][m][1];
                    f32x4 h0, h1; unpack8(hv[m][bj], h0, h1);
                    v0 = v0 + h0 * ALPHA; v1 = v1 + h1 * ALPHA;
                    acc[ai][bj][m][0] = v0; acc[ai][bj][m][1] = v1;
                    asm volatile("" : "+v"(acc[ai][bj][m][0]), "+v"(acc[ai][bj][m][1]) :: "memory");
                }
        }
#pragma unroll
        for (int ai = 0; ai < 2; ++ai)
#pragma unroll
            for (int m = 0; m < 4; ++m) {
                float sm = 0.f, sq = 0.f;
#pragma unroll
                for (int bj = 0; bj < 2; ++bj)
#pragma unroll
                    for (int n = 0; n < 2; ++n) { const f32x4 x = acc[ai][bj][m][n]; sm += (x[0] + x[1]) + (x[2] + x[3]); sq += (x[0] * x[0] + x[1] * x[1]) + (x[2] * x[2] + x[3] * x[3]); }
                sm += __shfl_xor(sm, 16); sm += __shfl_xor(sm, 32); sq += __shfl_xor(sq, 16); sq += __shfl_xor(sq, 32);
                if (fq == 0) P[(ai * 128 + wr * 64 + m * 16 + fr) * 4 + wc] = (f32x2){sm, sq};
            }
        LBAR();
        const int t = threadIdx.x;
        if (t < 256) { const f32x2 a = P[t * 4 + 0], b = P[t * 4 + 1], c = P[t * 4 + 2], d = P[t * 4 + 3];
            const float ts = (a[0] + b[0]) + (c[0] + d[0]), tq = (a[1] + b[1]) + (c[1] + d[1]);
            const unsigned long long pk = ((unsigned long long)__float_as_uint(tq) << 32) | (unsigned long long)__float_as_uint(ts);
            __hip_atomic_store(xslot + ((size_t)u.pm * 256 + t) * 8 + u.pn, pk, __ATOMIC_RELAXED, __HIP_MEMORY_SCOPE_AGENT); }
        asm volatile("s_waitcnt vmcnt(0)" ::: "memory");
        __syncthreads();
        unsigned* pc = cnt + (size_t)u.pm * 64;
        if (t == 0) {
            (void)__hip_atomic_fetch_add(pc, 1u, __ATOMIC_RELAXED, __HIP_MEMORY_SCOPE_AGENT);
            unsigned polls = 0;
            while (__hip_atomic_load(pc, __ATOMIC_RELAXED, __HIP_MEMORY_SCOPE_AGENT) < 8u) { __builtin_amdgcn_s_sleep(2); if (++polls > (1u << 22)) break; }
            __builtin_amdgcn_fence(__ATOMIC_ACQUIRE, "agent");
            asm volatile("s_waitcnt vmcnt(0)" ::: "memory");
        }
        __syncthreads();
        if (t < 256) { float ts = 0.f, tq = 0.f;
#pragma unroll
            for (int k = 0; k < 8; ++k) { const unsigned long long pk = __hip_atomic_load(xslot + ((size_t)u.pm * 256 + t) * 8 + k, __ATOMIC_RELAXED, __HIP_MEMORY_SCOPE_AGENT); ts += __uint_as_float((unsigned)pk); tq += __uint_as_float((unsigned)(pk >> 32)); }
            const float mean = ts * (1.f / D), var = fmaxf(tq * (1.f / D) - mean * mean, 0.f);
            S[t] = (f32x2){mean, rsqrtf(var + LN_EPS)}; }
        LBAR();
#pragma unroll
        for (int bj = 0; bj < 2; ++bj) {
            const int col = u.pn * 256 + bj * 128 + wc * 32 + 8 * fq;
            const f32x4 g0 = *(const f32x4*)(ln_g + col), g1 = *(const f32x4*)(ln_g + col + 4), b0 = *(const f32x4*)(ln_b + col), b1 = *(const f32x4*)(ln_b + col + 4);
#pragma unroll
            for (int ai = 0; ai < 2; ++ai)
#pragma unroll
                for (int m = 0; m < 4; ++m) {
                    const int rl = ai * 128 + wr * 64 + m * 16 + fr; const f32x2 st = S[rl];
                    const f32x4 v0 = acc[ai][bj][m][0], v1 = acc[ai][bj][m][1]; f32x4 y0, y1;
#pragma unroll
                    for (int j = 0; j < 4; ++j) { y0[j] = (v0[j] - st[0]) * st[1] * g0[j] + b0[j]; y1[j] = (v1[j] - st[0]) * st[1] * g1[j] + b1[j]; }
                    const size_t o = (size_t)(u.pm * 256 + rl) * D + col; *(v4u*)(H + o) = pack8(y0, y1);
                    v2u o8; o8.x = pk4_fp8(y0[0], y0[1], y0[2], y0[3]); o8.y = pk4_fp8(y1[0], y1[1], y1[2], y1[3]); *(v2u*)(X8 + o) = o8;
                    asm volatile("" ::: "memory"); __builtin_amdgcn_sched_barrier(0);
                }
        }
        LBAR();
    }
};
struct SchedPanel {
    int G, vcu, k, nM; const char* A; const char* B; size_t ta, tb;
    __device__ __forceinline__ bool get(int i, UnitD& u) const { if (i > 0) return false; const int L = k * G + vcu, pm = L >> 3, pn = L & 7; if (pm >= nM) return false;
        u.pm = pm; u.pn = pn; u.aux = pn * 256; u.slot = 0; u.A = A + (size_t)pm * ta; u.B = B + (size_t)pn * tb; return true; }
};

struct SchedDense {
    pg8::DenseOrder o; const char* A; const char* B; size_t ta, tb;
    __device__ __forceinline__ bool get(int i, UnitD& u) const { int pm, pn; if (!o.tile(i, pm, pn)) return false; u.pm = pm; u.pn = pn; u.aux = pn * 256; u.slot = 0; u.A = A + (size_t)pm * ta; u.B = B + (size_t)pn * tb; return true; }
};
struct SchedMerge {
    pg8::DenseOrder o; const char* A0; const char* A1; const char* B0; const char* B1; size_t ta, tb; int base, cnt;
    __device__ __forceinline__ bool get(int i0, UnitD& u) const { if (i0 >= cnt) return false; const int i = i0 + base; int pm, pn; if (!o.tile(i >> 1, pm, pn)) return false; const int part = i & 1; u.pm = pm; u.pn = pn; u.aux = part; u.slot = 0;
        u.A = (part ? A1 : A0) + (size_t)pm * ta; u.B = (part ? B1 : B0) + (size_t)pn * tb; return true; }
};
struct SchedGU {
    int G, vcu, ntiles; const char* X; const char* W; LAS const int* etab;
    __device__ __forceinline__ bool get(int i, UnitD& u) const { const int L = i * G + vcu, j = L >> 2; if (j >= ntiles || i >= 20) return false; const int e = etab[i];
        u.pm = j; u.pn = L & 3; u.aux = 0; u.slot = i; u.A = X; u.B = W + ((size_t)e * 1024 + (size_t)(L & 3) * 256) * (size_t)D; return true; }
};
struct SchedDown {
    int G, vcu, ntiles, chunk; const char* HB; const char* W; LAS const int* etab;
    __device__ __forceinline__ bool get(int i, UnitD& u) const { const int L = i * G + vcu, j = L >> 2; if (j >= ntiles || i >= 64) return false; const int e = etab[i], cc = L & 3;
        u.pm = j; u.pn = cc; u.aux = cc * 256; u.slot = 0; u.A = HB + (size_t)j * 256 * DE; u.B = W + ((size_t)e * 2048 + (size_t)(chunk * 4 + cc) * 256) * (size_t)DE; return true; }
};

#define XB_TMO      128
#define XB_XCNT(j)  (256  + 64 * (j))
#define XB_XSUB(j)  (1280 + 64 * (j))
#define XB_XGEN(j)  (2304 + 64 * (j))
#define XB_TOP      3328
#define XB_TOPGEN   3392
#define XCD_BAR_WORDS 3456
#define XB_SPIN_CAP (1u << 20)

__device__ __forceinline__ unsigned xb_ld(unsigned* p)              { return __hip_atomic_load(p, __ATOMIC_RELAXED, __HIP_MEMORY_SCOPE_AGENT); }
__device__ __forceinline__ unsigned xb_add(unsigned* p, unsigned v) { return __hip_atomic_fetch_add(p, v, __ATOMIC_RELAXED, __HIP_MEMORY_SCOPE_AGENT); }
__device__ __forceinline__ unsigned xb_xcc_id() { return (unsigned)__builtin_amdgcn_s_getreg((3 << 11) | 20) & 0xFu; }
#define XB_SPIN(cond, bar) do { unsigned _sp = 0; while (cond) { __builtin_amdgcn_s_sleep(1); \
    if ((++_sp & 255u) == 0u) { if (xb_ld(&(bar)[XB_TMO])) break; if (_sp > XB_SPIN_CAP) { atomicAdd(&(bar)[XB_TMO], 1u); break; } } } } while (0)

struct XcdBarrier { unsigned* bar; unsigned x; volatile LAS unsigned* st; };

__device__ __forceinline__ XcdBarrier xcd_barrier_post(unsigned* bar, volatile LAS unsigned* st) {
    XcdBarrier b; b.bar = bar; b.x = xb_xcc_id(); b.st = st;
    if (threadIdx.x == 0) (void)xb_add(&bar[XB_XCNT(b.x)], 1u);
    return b;
}
__device__ __forceinline__ void xcd_barrier_complete(unsigned* bar, unsigned x, unsigned& nloc, unsigned& nx) {
    const unsigned G = gridDim.x * gridDim.y * gridDim.z;
    unsigned sum, cnt, mine, sp = 0u;
    for (;;) {
        sum = 0u; cnt = 0u; mine = 0u;
#pragma unroll
        for (unsigned j = 0; j < 16; ++j) { const unsigned c = xb_ld(&bar[XB_XCNT(j)]); sum += c; cnt += (c > 0u) ? 1u : 0u; mine = (j == x) ? c : mine; }
        if (sum == G) break;
        __builtin_amdgcn_s_sleep(1);
        if ((++sp & 255u) == 0u) { if (xb_ld(&bar[XB_TMO])) break; if (sp > XB_SPIN_CAP) { atomicAdd(&bar[XB_TMO], 1u); break; } }
    }
    nloc = mine > 0u ? mine : 1u; nx = cnt > 0u ? cnt : 1u;
}
__device__ __forceinline__ void xcd_barrier(const XcdBarrier& b) {
    asm volatile("s_waitcnt vmcnt(0)" ::: "memory");
    __syncthreads();
    if (threadIdx.x == 0) {
        unsigned* bar = b.bar;
        __builtin_amdgcn_s_waitcnt(0);
        unsigned nloc = b.st[0], nx = b.st[1];
        if (nloc == 0u) { xcd_barrier_complete(bar, b.x, nloc, nx); b.st[0] = nloc; b.st[1] = nx; }
        const unsigned old = xb_add(&bar[XB_XSUB(b.x)], 1u);
        const unsigned gen = old / nloc;
        if (old + 1u == (gen + 1u) * nloc) {
            __builtin_amdgcn_fence(__ATOMIC_RELEASE, "agent");
            asm volatile("s_waitcnt vmcnt(0)" ::: "memory");
            const unsigned og = xb_add(&bar[XB_TOP], 1u);
            const unsigned tg = og / nx;
            if (og + 1u == (tg + 1u) * nx) xb_add(&bar[XB_TOPGEN], 1u);
            else XB_SPIN(xb_ld(&bar[XB_TOPGEN]) == tg, bar);
            __builtin_amdgcn_fence(__ATOMIC_ACQUIRE, "agent");
            xb_add(&bar[XB_XGEN(b.x)], 1u);
            asm volatile("s_waitcnt vmcnt(0)" ::: "memory");
        } else {
            XB_SPIN(xb_ld(&bar[XB_XGEN(b.x)]) == gen, bar);
            __builtin_amdgcn_fence(__ATOMIC_ACQUIRE, "agent");
            asm volatile("s_waitcnt vmcnt(0)" ::: "memory");
        }
    }
    __syncthreads();
}

constexpr int NWAVES = 8;
struct Frame {
    LAS unsigned char* lds;
    int tid, lane, wave, vcu, G;
    unsigned char* ws;
};

__device__ __forceinline__ void tr_item(const float* W, int ldw, int srccol0, bf16* WT, size_t dstrow0, int ldk, int k0, LAS float* scr, int lane) {
#pragma unroll 8
    for (int i = 0; i < 32; ++i) { const int kk = 2 * i + (lane >> 5); scr[kk * 33 + (lane & 31)] = __builtin_nontemporal_load(W + (size_t)(k0 + kk) * ldw + srccol0 + (lane & 31)); }
    LDS_WAIT(); asm volatile("" ::: "memory");
    const int c = lane & 7;
#pragma unroll
    for (int j = 0; j < 4; ++j) { const int n = (lane >> 3) + 8 * j; const LAS float* s = scr + (8 * c) * 33 + n;
        v4u o; o.x = pk2(s[0 * 33], s[1 * 33]); o.y = pk2(s[2 * 33], s[3 * 33]); o.z = pk2(s[4 * 33], s[5 * 33]); o.w = pk2(s[6 * 33], s[7 * 33]);
        *(v4u*)(WT + (dstrow0 + n) * (size_t)ldk + k0 + 8 * c) = o; }
    LDS_WAIT(); asm volatile("" ::: "memory");
}
__device__ __forceinline__ void tr_item8(const float* W, int ldw, int srccol0, unsigned char* WT, size_t dstrow0, int ldk, int k0, LAS float* scr, int lane) {
    float ld_[32];
#pragma unroll
    for (int i = 0; i < 32; ++i) { const int kk = 2 * i + (lane >> 5); ld_[i] = __builtin_nontemporal_load(W + (size_t)(k0 + kk) * ldw + srccol0 + (lane & 31)); }
#pragma unroll
    for (int i = 0; i < 32; ++i) { const int kk = 2 * i + (lane >> 5); scr[kk * 33 + (lane & 31)] = ld_[i]; }
    LDS_WAIT(); asm volatile("" ::: "memory");
    const int c = lane & 7;
#pragma unroll
    for (int j = 0; j < 4; ++j) { const int n = (lane >> 3) + 8 * j; const LAS float* s = scr + (8 * c) * 33 + n;
        v2u o; o.x = pk4_fp8(s[0 * 33] * W8_SCALE, s[1 * 33] * W8_SCALE, s[2 * 33] * W8_SCALE, s[3 * 33] * W8_SCALE); o.y = pk4_fp8(s[4 * 33] * W8_SCALE, s[5 * 33] * W8_SCALE, s[6 * 33] * W8_SCALE, s[7 * 33] * W8_SCALE);
        *(v2u*)(WT + (dstrow0 + n) * (size_t)ldk + k0 + 8 * c) = o; }
    LDS_WAIT(); asm volatile("" ::: "memory");
}
__device__ __forceinline__ void tr_matrix_item(const float* W, int K, int N, int ldw, int srcshift_from, int srcshift, bf16* WT, int item, LAS float* scr, int lane) {
    const int nblk = N / 32, kb = item / nblk, nb = item % nblk; const int n0 = nb * 32;
    const int sc0 = n0 + (n0 >= srcshift_from ? srcshift : 0);
    tr_item(W, ldw, sc0, WT, (size_t)n0, K, kb * 64, scr, lane);
}

__device__ __forceinline__ void tr_matrix_item8(const float* W, int K, int N, int ldw, int srcshift_from, int srcshift, unsigned char* WT, int item, LAS float* scr, int lane) {
    const int nblk = N / 32, kb = item / nblk, nb = item % nblk; const int n0 = nb * 32;
    const int sc0 = n0 + (n0 >= srcshift_from ? srcshift : 0);
    tr_item8(W, ldw, sc0, WT, (size_t)n0, K, kb * 64, scr, lane);
}
__device__ __forceinline__ void ln_stats32(const float (&v)[32], float& mean, float& rstd) {
    float s = 0.f;
#pragma unroll
    for (int i = 0; i < 32; ++i) s += v[i];
    mean = wave_sum(s) * (1.f / D);
    float q = 0.f;
#pragma unroll
    for (int i = 0; i < 32; ++i) { const float d = v[i] - mean; q += d * d; }
    rstd = rsqrtf(wave_sum(q) * (1.f / D) + LN_EPS);
}

__device__ __forceinline__ void p0_prologue(Frame& F, const float* x, const float* p, const float* ln_g, const float* ln_b, const float* w_in, const float* w_ba, const float* w_bm,
                                            const float* w_out, const float* w_router, const float* w_pp, const float* w_pg) {
    unsigned char* ws = F.ws;
    LAS float* scr = (LAS float*)(F.lds + RING_OFF + F.wave * 16384);
    const int gw = F.vcu * NWAVES + F.wave, NGW = F.G * NWAVES, lane = F.lane;
    constexpr int I_WIN = 32 * (NPROJ / 32), I_WB = 16 * 64, I_WOUT = 32 * 64, I_WR = 32 * 2, I_WPP = 4 * 64, I_WPG = 32 * 64;
    constexpr int NITEMS = I_WIN + 2 * I_WB + I_WOUT + I_WR + I_WPP + I_WPG;
    for (int it = gw; it < NITEMS; it += NGW) {
        int r = it;
        if (r < I_WIN) { if (FP8_P1) tr_matrix_item8(w_in, 2048, NPROJ, WIN_LD, 4352, 8, ws + WS_WIN, r, scr, lane); else tr_matrix_item(w_in, 2048, NPROJ, WIN_LD, 4352, 8, (bf16*)(ws + WS_WIN), r, scr, lane); continue; } r -= I_WIN;
        if (r < I_WB) { tr_matrix_item(w_ba, 1024, 2048, 2048, 1 << 30, 0, (bf16*)(ws + WS_WBA), r, scr, lane); continue; } r -= I_WB;
        if (r < I_WB) { tr_matrix_item(w_bm, 1024, 2048, 2048, 1 << 30, 0, (bf16*)(ws + WS_WBM), r, scr, lane); continue; } r -= I_WB;
        if (r < I_WOUT) { if (FP8_P6) tr_matrix_item8(w_out, 2048, 2048, 2048, 1 << 30, 0, ws + WS_WOUT, r, scr, lane); else tr_matrix_item(w_out, 2048, 2048, 2048, 1 << 30, 0, (bf16*)(ws + WS_WOUT), r, scr, lane); continue; } r -= I_WOUT;
        if (r < I_WR) { tr_matrix_item(w_router, 2048, 64, 64, 1 << 30, 0, (bf16*)(ws + WS_WR), r, scr, lane); continue; } r -= I_WR;
        if (r < I_WPP) { tr_matrix_item(w_pp, 256, 2048, 2048, 1 << 30, 0, (bf16*)(ws + WS_WPP), r, scr, lane); continue; } r -= I_WPP;
        if (FP8_P14) tr_matrix_item8(w_pg, 2048, 2048, 2048, 1 << 30, 0, ws + WS_WPG, r, scr, lane); else tr_matrix_item(w_pg, 2048, 2048, 2048, 1 << 30, 0, (bf16*)(ws + WS_WPG), r, scr, lane);
    }
    { bf16* PB = (bf16*)(ws + WS_PB);
      for (size_t i = ((size_t)blockIdx.x * 512 + F.tid) * 8; i < (size_t)T * 256; i += (size_t)F.G * 512 * 8) {
          const f32x4 a = *(const f32x4*)(p + i), b = *(const f32x4*)(p + i + 4); *(v4u*)(PB + i) = pack8(a, b); } }
    __syncthreads();
    LAS float* wif = (LAS float*)(F.lds + RING_OFF);
    for (int idx = F.tid; idx < 8 * 2048; idx += 512) { const int g = idx & 7, k = idx >> 3; wif[g * 2048 + k] = w_in[(size_t)k * WIN_LD + 4352 + g]; }
    __syncthreads();
    bf16* H = (bf16*)(ws + WS_H); float* GIF = (float*)(ws + WS_GIF);
    f32x4 pre[8];
    if (gw < T) {
#pragma unroll
        for (int j = 0; j < 8; ++j) pre[j] = __builtin_nontemporal_load((const f32x4*)(x + (size_t)gw * D) + lane + 64 * j);
    }
    for (int m = gw; m < T; m += NGW) {
        f32x4 v[8]; float s = 0.f;
#pragma unroll
        for (int j = 0; j < 8; ++j) { v[j] = pre[j]; s += (v[j][0] + v[j][1]) + (v[j][2] + v[j][3]); }
        if (m + NGW < T) {
#pragma unroll
            for (int j = 0; j < 8; ++j) pre[j] = __builtin_nontemporal_load((const f32x4*)(x + (size_t)(m + NGW) * D) + lane + 64 * j);
        }
        const float mean = wave_sum(s) * (1.f / D); float q = 0.f;
#pragma unroll
        for (int j = 0; j < 8; ++j) { v[j] = v[j] - mean; q += (v[j][0] * v[j][0] + v[j][1] * v[j][1]) + (v[j][2] * v[j][2] + v[j][3] * v[j][3]); }
        const float rstd = rsqrtf(wave_sum(q) * (1.f / D) + LN_EPS);
        float ga[8];
#pragma unroll
        for (int g = 0; g < 8; ++g) ga[g] = 0.f;
#pragma unroll
        for (int j = 0; j < 8; ++j) {
            const f32x4 g4 = ((const f32x4*)ln_g)[lane + 64 * j], b4 = ((const f32x4*)ln_b)[lane + 64 * j];
            const f32x4 y = v[j] * rstd * g4 + b4;
            v2u o; o.x = pk2(y[0], y[1]); o.y = pk2(y[2], y[3]);
            __builtin_nontemporal_store(o, (v2u*)(H + (size_t)m * D + 256 * j + 4 * lane));
            if (FP8_P1) *(unsigned*)(ws + WS_H8 + (size_t)m * D + 256 * j + 4 * lane) = pk4_fp8(y[0], y[1], y[2], y[3]);
#pragma unroll
            for (int g = 0; g < 8; ++g) { const f32x4 w4 = *(const LAS f32x4*)(wif + g * 2048 + 256 * j + 4 * lane); ga[g] += (y[0] * w4[0] + y[1] * w4[1]) + (y[2] * w4[2] + y[3] * w4[3]); }
            asm volatile("" ::: "memory"); __builtin_amdgcn_sched_barrier(0);
        }
#pragma unroll
        for (int g = 0; g < 8; ++g) ga[g] = wave_sum(ga[g]);
        if (lane == 0) { *(f32x4*)(GIF + (size_t)m * 8) = (f32x4){ga[0], ga[1], ga[2], ga[3]}; *(f32x4*)(GIF + (size_t)m * 8 + 4) = (f32x4){ga[4], ga[5], ga[6], ga[7]}; }
    }
    __syncthreads();
}

constexpr int ATT_K_OFF = 0, ATT_KS = 72, ATT_VT_OFF = 256 * 72 * 2, ATT_VS = 264;
__device__ __forceinline__ void attn_unit(Frame& F, int unit, bf16* PROJ, const float* sinks) {
    const int b = unit >> 8, blk = (unit & 255) >> 1, hkv = unit & 1;
    const int tok0 = b * SEQ + blk * 128, ktok0 = tok0 - 128;
    LAS bf16* Ks = (LAS bf16*)(F.lds + RING_OFF + ATT_K_OFF); LAS bf16* Vt = (LAS bf16*)(F.lds + RING_OFF + ATT_VT_OFF);
    for (int pidx = F.tid; pidx < 2048; pidx += 512) {
        const int kj = pidx >> 3, c8 = pidx & 7; int tk = ktok0 + kj; if (blk == 0 && kj < 128) tk = tok0;
        const size_t so = (size_t)tk * 128 + 64 * hkv + 8 * c8;
        const v4u kv = *(const v4u*)(PSEG(PROJ, C_K) + so), vv = *(const v4u*)(PSEG(PROJ, C_V) + so);
        *(LAS v4u*)(Ks + kj * ATT_KS + 8 * c8) = kv;
        LAS bf16* vd = Vt + (8 * c8) * ATT_VS + ((((kj >> 3) ^ c8) << 3) | (kj & 7));
        vd[0 * ATT_VS] = (bf16)(vv.x & 0xffffu); vd[1 * ATT_VS] = (bf16)(vv.x >> 16); vd[2 * ATT_VS] = (bf16)(vv.y & 0xffffu); vd[3 * ATT_VS] = (bf16)(vv.y >> 16);
        vd[4 * ATT_VS] = (bf16)(vv.z & 0xffffu); vd[5 * ATT_VS] = (bf16)(vv.z >> 16); vd[6 * ATT_VS] = (bf16)(vv.w & 0xffffu); vd[7 * ATT_VS] = (bf16)(vv.w >> 16);
    }
    LBAR();
    const int lane = F.lane, fr = lane & 15, fq = lane >> 4, h = hkv * 8 + F.wave;
    const float slope_l2 = fast_exp2(-0.5f * (float)(h + 1)) * LOG2E, sink_l2 = sinks[h] * LOG2E;
    bf16x8 qn[2];
#pragma unroll
    for (int ks = 0; ks < 2; ++ks) qn[ks] = *(const bf16x8*)(PSEG(PROJ, C_Q) + (size_t)(tok0 + fr) * 1024 + 64 * h + 32 * ks + 8 * fq);
    for (int qc = 0; qc < 8; ++qc) {
        const int qi = 16 * qc + fr; bf16* qrow = PSEG(PROJ, C_Q) + (size_t)(tok0 + qi) * 1024 + 64 * h;
        bf16x8 qf[2];
#pragma unroll
        for (int ks = 0; ks < 2; ++ks) qf[ks] = qn[ks];
        if (qc < 7) {
#pragma unroll
            for (int ks = 0; ks < 2; ++ks) qn[ks] = *(const bf16x8*)(qrow + (size_t)16 * 1024 + 32 * ks + 8 * fq);
        }
        const int tb = qc & ~1;
        f32x4 s[10];
#pragma unroll
        for (int tt = 0; tt < 10; ++tt) {
            s[tt] = (f32x4){0.f, 0.f, 0.f, 0.f};
#pragma unroll
            for (int ks = 0; ks < 2; ++ks) { const bf16x8 kf = *(const LAS bf16x8*)(Ks + (16 * (tb + tt) + fr) * ATT_KS + 32 * ks + 8 * fq); s[tt] = __builtin_amdgcn_mfma_f32_16x16x32_bf16(kf, qf[ks], s[tt], 0, 0, 0); }
        }
        float mx = sink_l2;
#pragma unroll
        for (int tt = 0; tt < 10; ++tt)
#pragma unroll
            for (int r = 0; r < 4; ++r) { const int kj = 16 * (tb + tt) + 4 * fq + r; const bool valid = (kj > qi) && (kj <= qi + 128) && (blk > 0 || kj >= 128);
                const float val = s[tt][r] - slope_l2 * (float)(qi + 128 - kj); s[tt][r] = valid ? val : -INFINITY; mx = fmaxf(mx, s[tt][r]); }
        mx = fmaxf(mx, __shfl_xor(mx, 16)); mx = fmaxf(mx, __shfl_xor(mx, 32));
        float l = 0.f;
#pragma unroll
        for (int tt = 0; tt < 10; ++tt)
#pragma unroll
            for (int r = 0; r < 4; ++r) { const float pv = fast_exp2(s[tt][r] - mx); s[tt][r] = pv; l += pv; }
        l += __shfl_xor(l, 16); l += __shfl_xor(l, 32); l += fast_exp2(sink_l2 - mx);
        f32x4 o[4];
#pragma unroll
        for (int dt = 0; dt < 4; ++dt) o[dt] = (f32x4){0.f, 0.f, 0.f, 0.f};
#pragma unroll
        for (int pp = 0; pp < 5; ++pp) {
            v4u pw; pw.x = pk2(s[2 * pp][0], s[2 * pp][1]); pw.y = pk2(s[2 * pp][2], s[2 * pp][3]); pw.z = pk2(s[2 * pp + 1][0], s[2 * pp + 1][1]); pw.w = pk2(s[2 * pp + 1][2], s[2 * pp + 1][3]);
            const bf16x8 pf = __builtin_bit_cast(bf16x8, pw);
            const int kb = 16 * (tb + 2 * pp);
#pragma unroll
            for (int dt = 0; dt < 4; ++dt) {
                const int drow = 16 * dt + fr, dx = (drow >> 3) & 7, k0 = kb + 4 * fq;
                const LAS bf16* vrow_ = Vt + drow * ATT_VS;
                const v2u va = *(const LAS v2u*)(vrow_ + ((((k0 >> 3) ^ dx) << 3) | (k0 & 7))), vb = *(const LAS v2u*)(vrow_ + (((((k0 + 16) >> 3) ^ dx) << 3) | (k0 & 7)));
                v4u vw; vw.x = va.x; vw.y = va.y; vw.z = vb.x; vw.w = vb.y;
                o[dt] = __builtin_amdgcn_mfma_f32_16x16x32_bf16(__builtin_bit_cast(bf16x8, vw), pf, o[dt], 0, 0, 0);
            }
        }
        const float inv = fast_rcp(l);
#pragma unroll
        for (int dt = 0; dt < 4; ++dt) { v2u ov; ov.x = pk2(o[dt][0] * inv, o[dt][1] * inv); ov.y = pk2(o[dt][2] * inv, o[dt][3] * inv); *(v2u*)(qrow + 16 * dt + 4 * fq) = ov; }
    }
    LBAR();
}

__device__ __forceinline__ void mlstm_gates(const float* GIF, const float* b_i, const float* b_f, int t, int h, float& ig, float& lf) {
    const float ip = GIF[(size_t)t * 8 + h] + b_i[h], fp = GIF[(size_t)t * 8 + 4 + h] + b_f[h];
    ig = 15.0f * tanhf(ip * (1.0f / 15.0f));
    const float fc = 15.0f * tanhf(fp * (1.0f / 15.0f));
    lf = fminf(fc, 0.f) - log1pf(expf(-fabsf(fc)));
}
__device__ __forceinline__ float wave_incl_scan_add(float v, int lane) {
#pragma unroll
    for (int o = 1; o < 64; o <<= 1) { const float n = __shfl_up(v, o); if (lane >= o) v += n; }
    return v;
}
__device__ __forceinline__ float wave_incl_scan_max(float v, int lane) {
#pragma unroll
    for (int o = 1; o < 64; o <<= 1) { const float n = __shfl_up(v, o); if (lane >= o) v = fmaxf(v, n); }
    return v;
}
__device__ __forceinline__ int swz72(int r, int sc) { return r * 72 + ((((sc >> 3) ^ ((r >> 3) & 7)) << 3) | (sc & 7)); }
constexpr int ML_S = 72;
__device__ __forceinline__ void mlstm_a_unit(Frame& F, int unit, const bf16* PROJ, const float* GIF, const float* b_i, const float* b_f, bf16* DC, float* SC, float* DN) {
    const int seq = unit >> 8, c = unit & 255, b = seq >> 2, h = seq & 3, t0 = b * SEQ + 64 * c, lane = F.lane;
    LAS bf16* Kt = (LAS bf16*)(F.lds + RING_OFF); LAS bf16* Vt = (LAS bf16*)(F.lds + RING_OFF + 128 * ML_S * 2); LAS float* wgl = (LAS float*)(F.lds + RING_OFF + (128 + 256) * ML_S * 2);
    v4u kvr[2], vvr[4];
#pragma unroll
    for (int k = 0; k < 2; ++k) { const int pidx = F.tid + 512 * k; kvr[k] = *(const v4u*)(PSEG(PROJ, C_MK) + (size_t)(t0 + (pidx >> 4)) * 512 + 128 * h + 8 * (pidx & 15)); }
#pragma unroll
    for (int k = 0; k < 4; ++k) { const int pidx = F.tid + 512 * k; vvr[k] = *(const v4u*)(PSEG(PROJ, C_MV) + (size_t)(t0 + (pidx >> 5)) * 1024 + 256 * h + 8 * (pidx & 31)); }
    if (F.wave == 0) {
        float ig, lf; mlstm_gates(GIF, b_i, b_f, t0 + lane, h, ig, lf);
        const float bc = wave_incl_scan_add(lf, lane), bl = __shfl(bc, 63), g = bl - bc + ig, gmax = wave_max(g);
        wgl[lane] = expf(g - gmax);
        if (lane == 0) { SC[unit * 2] = bl; SC[unit * 2 + 1] = gmax; }
    }
#pragma unroll
    for (int kk = 0; kk < 4; ++kk) {
        const int pidx = F.tid + 512 * kk;
        const int s = pidx >> 5, c8 = pidx & 31;
        const v4u vv = vvr[kk];
        LAS bf16* vd = Vt + (8 * c8) * ML_S + ((((s >> 3) ^ (c8 & 7)) << 3) | (s & 7));
        vd[0 * ML_S] = (bf16)(vv.x & 0xffffu); vd[1 * ML_S] = (bf16)(vv.x >> 16); vd[2 * ML_S] = (bf16)(vv.y & 0xffffu); vd[3 * ML_S] = (bf16)(vv.y >> 16);
        vd[4 * ML_S] = (bf16)(vv.z & 0xffffu); vd[5 * ML_S] = (bf16)(vv.z >> 16); vd[6 * ML_S] = (bf16)(vv.w & 0xffffu); vd[7 * ML_S] = (bf16)(vv.w >> 16);
    }
    LBAR();
#pragma unroll
    for (int kk = 0; kk < 2; ++kk) {
        const int pidx = F.tid + 512 * kk;
        const int s = pidx >> 4, c8 = pidx & 15; const float w = wgl[s];
        const v4u kv = kvr[kk];
        LAS bf16* kd = Kt + (8 * c8) * ML_S + ((((s >> 3) ^ (c8 & 7)) << 3) | (s & 7));
        kd[0 * ML_S] = (bf16)f2bf(bflo(kv.x) * w); kd[1 * ML_S] = (bf16)f2bf(bfhi(kv.x) * w); kd[2 * ML_S] = (bf16)f2bf(bflo(kv.y) * w); kd[3 * ML_S] = (bf16)f2bf(bfhi(kv.y) * w);
        kd[4 * ML_S] = (bf16)f2bf(bflo(kv.z) * w); kd[5 * ML_S] = (bf16)f2bf(bfhi(kv.z) * w); kd[6 * ML_S] = (bf16)f2bf(bflo(kv.w) * w); kd[7 * ML_S] = (bf16)f2bf(bfhi(kv.w) * w);
    }
    LBAR();
    if (F.tid < 128) { float sn = 0.f;
#pragma unroll 8
        for (int s = 0; s < 64; ++s) sn += bf2f(Kt[F.tid * ML_S + s]);
        DN[(size_t)unit * 128 + F.tid] = sn; }
    const int fr = lane & 15, fq = lane >> 4, w = F.wave;
    bf16x8 yf[2][2];
#pragma unroll
    for (int vi = 0; vi < 2; ++vi)
#pragma unroll
        for (int ks = 0; ks < 2; ++ks) yf[vi][ks] = *(const LAS bf16x8*)(Vt + swz72(16 * (2 * w + vi) + fr, 32 * ks + 8 * fq));
    bf16* dst = DC + (size_t)unit * 32768;
#pragma unroll
    for (int dt = 0; dt < 8; ++dt) {
        bf16x8 xf[2];
#pragma unroll
        for (int ks = 0; ks < 2; ++ks) xf[ks] = *(const LAS bf16x8*)(Kt + swz72(16 * dt + fr, 32 * ks + 8 * fq));
#pragma unroll
        for (int vi = 0; vi < 2; ++vi) {
            f32x4 a = zero_acc();
            a = __builtin_amdgcn_mfma_f32_16x16x32_bf16(xf[0], yf[vi][0], a, 0, 0, 0);
            a = __builtin_amdgcn_mfma_f32_16x16x32_bf16(xf[1], yf[vi][1], a, 0, 0, 0);
            v2u o; o.x = pk2(a[0], a[1]); o.y = pk2(a[2], a[3]);
            *(v2u*)(dst + (size_t)(16 * (2 * w + vi) + fr) * 128 + 16 * dt + 4 * fq) = o;
        }
    }
    LBAR();
}
__device__ __forceinline__ void mlstm_scan(Frame& F, bf16* DC, const float* SC, const float* DN, float* NST, float* MS) {
    LAS float* tm = (LAS float*)(F.lds + RING_OFF);
    LAS f32x2* tds = (LAS f32x2*)(F.lds + RING_OFF + 2048);
    for (int base = blockIdx.x * 512; base < 8 * 16384; base += F.G * 512) {
        const int seq = base >> 14; const float* sc = SC + (size_t)seq * 512;
        __syncthreads();
        if (F.wave == 0) {
            const int lane = F.lane; float B[4], Gm[4];
            { const f32x4 s0 = *(const f32x4*)(sc + 8 * lane), s1 = *(const f32x4*)(sc + 8 * lane + 4); B[0] = s0[0]; Gm[0] = s0[1]; B[1] = s0[2]; Gm[1] = s0[3]; B[2] = s1[0]; Gm[2] = s1[1]; B[3] = s1[2]; Gm[3] = s1[3]; }
            float TB = B[0], TG = Gm[0];
#pragma unroll
            for (int k = 1; k < 4; ++k) { TG = fmaxf(TG + B[k], Gm[k]); TB += B[k]; }
            float PB = TB, PG = TG;
#pragma unroll
            for (int o = 1; o < 64; o <<= 1) { const float oB = __shfl_up(PB, o), oG = __shfl_up(PG, o); if (lane >= o) { PG = fmaxf(oG + PB, PG); PB = oB + PB; } }
            float eB = __shfl_up(PB, 1), eG = __shfl_up(PG, 1); if (lane == 0) { eB = 0.f; eG = -INFINITY; }
            float m = fmaxf(0.f + eB, eG);
#pragma unroll
            for (int k = 0; k < 4; ++k) { tm[4 * lane + k] = m; m = fmaxf(m + B[k], Gm[k]); }
            if (lane == 63) tm[256] = m;
        }
        __syncthreads();
        if (F.tid < 256) { const int c = F.tid; const float bl = sc[2 * c], gmax = sc[2 * c + 1], m = tm[c], mn = tm[c + 1]; tds[c] = (f32x2){expf(bl + m - mn), expf(gmax - mn)}; }
        __syncthreads();
        const int pr = (base & 16383) + F.tid;
        unsigned* ptr = (unsigned*)(DC + (size_t)seq * 256 * 32768) + pr;
        float C0 = 0.f, C1 = 0.f;
        unsigned nx[16];
#pragma unroll
        for (int j = 0; j < 16; ++j) nx[j] = ptr[(size_t)j * 16384];
        for (int c0 = 0; c0 < 256; c0 += 16) {
            unsigned d[16];
#pragma unroll
            for (int j = 0; j < 16; ++j) d[j] = nx[j];
            if (c0 + 16 < 256) {
#pragma unroll
                for (int j = 0; j < 16; ++j) nx[j] = ptr[(size_t)(c0 + 16 + j) * 16384];
            }
#pragma unroll
            for (int j = 0; j < 16; ++j) {
                const f32x2 ds_ = tds[c0 + j];
                ptr[(size_t)(c0 + j) * 16384] = pk2(C0, C1);
                C0 = ds_[0] * C0 + ds_[1] * bflo(d[j]); C1 = ds_[0] * C1 + ds_[1] * bfhi(d[j]);
            }
        }
        if ((base & 16383) == 0 && F.tid < 128) {
            const int dd = F.tid; float n = 0.f;
            for (int c0 = 0; c0 < 256; c0 += 32) {
                float dn[32];
#pragma unroll
                for (int j = 0; j < 32; ++j) dn[j] = DN[(size_t)(seq * 256 + c0 + j) * 128 + dd];
#pragma unroll
                for (int j = 0; j < 32; ++j) { const f32x2 ds_ = tds[c0 + j]; NST[(size_t)(seq * 256 + c0 + j) * 128 + dd] = n; n = ds_[0] * n + ds_[1] * dn[j]; }
            }
            MS[seq * 256 + dd] = tm[dd]; MS[seq * 256 + 128 + dd] = tm[128 + dd];
        }
    }
    __syncthreads();
}
constexpr int MC_VT = 0, MC_SQ = 256 * ML_S * 2, MC_SA = MC_SQ + 64 * ML_S * 2, MC_SM = MC_SA + 256, MC_SI = MC_SM + 256, MC_SE = MC_SI + 256, MC_RED = MC_SE + 256, MC_NST = MC_RED + 512, MC_CT = MC_NST + 512, MC_CTS = 136;
__device__ __forceinline__ void mlstm_c_preload(Frame& F, int unit, const bf16* PROJ, const bf16* DC, v4u (&ctr)[8], v4u (&vvr)[4]) {
    const int seq = unit >> 8, c = unit & 255, b = seq >> 2, h = seq & 3, t0 = b * SEQ + 64 * c;
    const bf16* ct = DC + (size_t)unit * 32768;
#pragma unroll
    for (int k = 0; k < 8; ++k) { const int idx = F.tid + 512 * k; ctr[k] = *(const v4u*)(ct + (size_t)(idx >> 4) * 128 + 8 * (idx & 15)); }
#pragma unroll
    for (int k = 0; k < 4; ++k) { const int pidx = F.tid + 512 * k; vvr[k] = *(const v4u*)(PSEG(PROJ, C_MV) + (size_t)(t0 + (pidx >> 5)) * 1024 + 256 * h + 8 * (pidx & 31)); }
}
__device__ __forceinline__ void mlstm_c_unit(Frame& F, int unit, int unit_next, v4u (&ctr)[8], v4u (&vvr)[4], bf16* PROJ, const float* GIF, const float* b_i, const float* b_f, const bf16* DC, const float* NST, const float* MS, const float* norm_g) {
    const int seq = unit >> 8, c = unit & 255, b = seq >> 2, h = seq & 3, t0 = b * SEQ + 64 * c, lane = F.lane, fr = lane & 15, fq = lane >> 4, w = F.wave;
    LAS unsigned char* L = F.lds + RING_OFF;
    LAS bf16* Vt = (LAS bf16*)(L + MC_VT); LAS bf16* SQ = (LAS bf16*)(L + MC_SQ); LAS bf16* CtL = (LAS bf16*)(L + MC_CT);
    LAS float* sA = (LAS float*)(L + MC_SA); LAS float* sM = (LAS float*)(L + MC_SM); LAS float* sSi = (LAS float*)(L + MC_SI); LAS float* sE = (LAS float*)(L + MC_SE); LAS float* red = (LAS float*)(L + MC_RED); LAS float* nl = (LAS float*)(L + MC_NST);
    const int tt = w >> 1, hf = w & 1;
    bf16x8 xq[4], yk[2][4];
    { const bf16* qrow = PSEG(PROJ, C_MQ) + (size_t)(t0 + 16 * tt + fr) * 512 + 128 * h + 8 * fq;
#pragma unroll
      for (int ks = 0; ks < 4; ++ks) xq[ks] = *(const bf16x8*)(qrow + 32 * ks); }
#pragma unroll
    for (int si = 0; si < 2; ++si) { const int st = 2 * hf + si;
        if (st <= tt) { const bf16* krow = PSEG(PROJ, C_MK) + (size_t)(t0 + 16 * st + fr) * 512 + 128 * h + 8 * fq;
#pragma unroll
            for (int ks = 0; ks < 4; ++ks) yk[si][ks] = *(const bf16x8*)(krow + 32 * ks); }
        else {
#pragma unroll
            for (int ks = 0; ks < 4; ++ks) yk[si][ks] = (bf16x8){0, 0, 0, 0, 0, 0, 0, 0}; } }
    const bf16* morow = PSEG(PROJ, C_MO) + (size_t)(t0 + 16 * tt + fr) * 1024 + 256 * h; bf16* mhrow = PSEG(PROJ, C_MV) + (size_t)(t0 + 16 * tt + fr) * 1024 + 256 * h;
    v2u mo[8]; f32x4 ng[8];
#pragma unroll
    for (int vi = 0; vi < 8; ++vi) { const int v0 = 16 * (8 * hf + vi) + 4 * fq; mo[vi] = *(const v2u*)(morow + v0); ng[vi] = *(const f32x4*)(norm_g + 256 * h + v0); }
    if (F.tid < 32) *(LAS f32x4*)(nl + 4 * F.tid) = *(const f32x4*)(NST + (size_t)unit * 128 + 4 * F.tid);
    if (w == 0) {
        float ig, lf; mlstm_gates(GIF, b_i, b_f, t0 + lane, h, ig, lf);
        const float bc = wave_incl_scan_add(lf, lane), a = ig - bc, pm = wave_incl_scan_max(a, lane), mc = MS[unit], Mt = fmaxf(mc, pm);
        sA[lane] = a; sM[lane] = Mt; sSi[lane] = expf(mc - Mt); sE[lane] = expf(-(bc + Mt));
    }
#pragma unroll
    for (int k = 0; k < 4; ++k) { const int pidx = F.tid + 512 * k, s = pidx >> 5, c8 = pidx & 31; const v4u vv = vvr[k];
        LAS bf16* vd = Vt + (8 * c8) * ML_S + ((((s >> 3) ^ (c8 & 7)) << 3) | (s & 7));
        vd[0 * ML_S] = (bf16)(vv.x & 0xffffu); vd[1 * ML_S] = (bf16)(vv.x >> 16); vd[2 * ML_S] = (bf16)(vv.y & 0xffffu); vd[3 * ML_S] = (bf16)(vv.y >> 16);
        vd[4 * ML_S] = (bf16)(vv.z & 0xffffu); vd[5 * ML_S] = (bf16)(vv.z >> 16); vd[6 * ML_S] = (bf16)(vv.w & 0xffffu); vd[7 * ML_S] = (bf16)(vv.w >> 16); }
#pragma unroll
    for (int k = 0; k < 8; ++k) { const int idx = F.tid + 512 * k; *(LAS v4u*)(CtL + (idx >> 4) * MC_CTS + 8 * (idx & 15)) = ctr[k]; }
    if (unit_next >= 0) mlstm_c_preload(F, unit_next, PROJ, DC, ctr, vvr);
    LBAR();
#pragma unroll
    for (int si = 0; si < 2; ++si) {
        const int st = 2 * hf + si;
        f32x4 sv = zero_acc();
        if (st <= tt) {
#pragma unroll
            for (int ks = 0; ks < 4; ++ks) sv = __builtin_amdgcn_mfma_f32_16x16x32_bf16(xq[ks], yk[si][ks], sv, 0, 0, 0);
        }
        const int sidx = 16 * st + fr; const float as = sA[sidx];
#pragma unroll
        for (int r = 0; r < 4; ++r) { const int tix = 16 * tt + 4 * fq + r; const float wv = (sidx <= tix) ? expf(as - sM[tix]) : 0.f; SQ[tix * ML_S + sidx] = (bf16)f2bf(sv[r] * wv); }
    }
    LBAR();
    bf16x8 xf[6];
    { const float sit = sSi[16 * tt + fr];
#pragma unroll
      for (int ks = 0; ks < 4; ++ks) { const v4u qv = __builtin_bit_cast(v4u, xq[ks]); v4u o; o.x = pk2(bflo(qv.x) * sit, bfhi(qv.x) * sit); o.y = pk2(bflo(qv.y) * sit, bfhi(qv.y) * sit);
          o.z = pk2(bflo(qv.z) * sit, bfhi(qv.z) * sit); o.w = pk2(bflo(qv.w) * sit, bfhi(qv.w) * sit); xf[ks] = __builtin_bit_cast(bf16x8, o); }
#pragma unroll
      for (int ks = 0; ks < 2; ++ks) xf[4 + ks] = *(const LAS bf16x8*)(SQ + (16 * tt + fr) * ML_S + 32 * ks + 8 * fq); }
    float nq;
    { f32x4 an = zero_acc();
#pragma unroll
      for (int ks = 0; ks < 6; ++ks) {
          v4u yn = (v4u){0u, 0u, 0u, 0u};
          if (fr == 0) { if (ks < 4) { const f32x4 n0 = *(const LAS f32x4*)(nl + 32 * ks + 8 * fq), n1 = *(const LAS f32x4*)(nl + 32 * ks + 8 * fq + 4); yn = pack8(n0, n1); } else yn = (v4u){0x3f803f80u, 0x3f803f80u, 0x3f803f80u, 0x3f803f80u}; }
          an = __builtin_amdgcn_mfma_f32_16x16x32_bf16(__builtin_bit_cast(bf16x8, yn), xf[ks], an, 0, 0, 0);
      }
      nq = __shfl(an[0], fr); }
    const float den = fmaxf(fabsf(nq), sE[16 * tt + fr]), rden = 1.0f / den;
    f32x4 acc[8];
#pragma unroll
    for (int vi = 0; vi < 8; ++vi) {
        const int vrow = 16 * (8 * hf + vi) + fr;
        f32x4 a = zero_acc();
#pragma unroll
        for (int ks = 0; ks < 4; ++ks) { const bf16x8 yc = *(const LAS bf16x8*)(CtL + vrow * MC_CTS + 32 * ks + 8 * fq); a = __builtin_amdgcn_mfma_f32_16x16x32_bf16(yc, xf[ks], a, 0, 0, 0); }
#pragma unroll
        for (int ks = 0; ks < 2; ++ks) { const bf16x8 yv = *(const LAS bf16x8*)(Vt + swz72(vrow, 32 * ks + 8 * fq)); a = __builtin_amdgcn_mfma_f32_16x16x32_bf16(yv, xf[4 + ks], a, 0, 0, 0); }
        acc[vi] = a * rden;
    }
    float ssq = 0.f;
#pragma unroll
    for (int vi = 0; vi < 8; ++vi) ssq += (acc[vi][0] * acc[vi][0] + acc[vi][1] * acc[vi][1]) + (acc[vi][2] * acc[vi][2] + acc[vi][3] * acc[vi][3]);
    ssq += __shfl_xor(ssq, 16); ssq += __shfl_xor(ssq, 32);
    if (fq == 0) red[(16 * tt + fr) * 2 + hf] = ssq;
    LBAR();
    const float tot = red[(16 * tt + fr) * 2] + red[(16 * tt + fr) * 2 + 1];
    const float rs = rsqrtf(tot * (1.0f / 256.0f) + RMS_EPS);
#pragma unroll
    for (int vi = 0; vi < 8; ++vi) {
        const int v0 = 16 * (8 * hf + vi) + 4 * fq;
        v2u o; o.x = pk2(acc[vi][0] * rs * ng[vi][0] * bflo(mo[vi].x), acc[vi][1] * rs * ng[vi][1] * bfhi(mo[vi].x)); o.y = pk2(acc[vi][2] * rs * ng[vi][2] * bflo(mo[vi].y), acc[vi][3] * rs * ng[vi][3] * bfhi(mo[vi].y));
        *(v2u*)(mhrow + v0) = o;
    }
    LBAR();
}

template <int R, class StF>
__device__ __forceinline__ void ln_multi(const v4u (&rw)[R][4], const float* g, const float* bta, int lane, StF&& st) {
    float v[R][32]; float sm[R], sq[R];
#pragma unroll
    for (int r = 0; r < R; ++r) { sm[r] = 0.f;
#pragma unroll
        for (int j = 0; j < 4; ++j) { f32x4 a, b; unpack8(rw[r][j], a, b);
#pragma unroll
            for (int i = 0; i < 4; ++i) { v[r][8 * j + i] = a[i]; v[r][8 * j + 4 + i] = b[i]; sm[r] += a[i] + b[i]; } } }
#pragma unroll
    for (int o = 1; o < 64; o <<= 1) {
#pragma unroll
        for (int r = 0; r < R; ++r) sm[r] += __shfl_xor(sm[r], o);
    }
#pragma unroll
    for (int r = 0; r < R; ++r) { sm[r] *= (1.f / D); sq[r] = 0.f;
#pragma unroll
        for (int i = 0; i < 32; ++i) { const float d = v[r][i] - sm[r]; sq[r] += d * d; } }
#pragma unroll
    for (int o = 1; o < 64; o <<= 1) {
#pragma unroll
        for (int r = 0; r < R; ++r) sq[r] += __shfl_xor(sq[r], o);
    }
#pragma unroll
    for (int r = 0; r < R; ++r) sq[r] = rsqrtf(sq[r] * (1.f / D) + LN_EPS);
#pragma unroll
    for (int j = 0; j < 4; ++j) {
        const f32x4 g0 = *(const f32x4*)(g + 512 * j + 8 * lane), g1 = *(const f32x4*)(g + 512 * j + 8 * lane + 4), b0 = *(const f32x4*)(bta + 512 * j + 8 * lane), b1 = *(const f32x4*)(bta + 512 * j + 8 * lane + 4);
#pragma unroll
        for (int r = 0; r < R; ++r) { f32x4 a, b;
#pragma unroll
            for (int i = 0; i < 4; ++i) { a[i] = (v[r][8 * j + i] - sm[r]) * sq[r] * g0[i] + b0[i]; b[i] = (v[r][8 * j + 4 + i] - sm[r]) * sq[r] * g1[i] + b1[i]; }
            st(r, j, a, b); }
    }
}
__device__ __forceinline__ void ln_row_inplace(bf16* row, unsigned char* row8, const float* g, const float* bta, int lane, const v4u (&rw)[4]) {
    float v[32];
#pragma unroll
    for (int j = 0; j < 4; ++j) { const v4u w = rw[j]; f32x4 a, b; unpack8(w, a, b);
#pragma unroll
        for (int i = 0; i < 4; ++i) { v[8 * j + i] = a[i]; v[8 * j + 4 + i] = b[i]; } }
    float mean, rstd; ln_stats32(v, mean, rstd);
#pragma unroll
    for (int j = 0; j < 4; ++j) { const f32x4 g0 = *(const f32x4*)(g + 512 * j + 8 * lane), g1 = *(const f32x4*)(g + 512 * j + 8 * lane + 4), b0 = *(const f32x4*)(bta + 512 * j + 8 * lane), b1 = *(const f32x4*)(bta + 512 * j + 8 * lane + 4);
        f32x4 a, b;
#pragma unroll
        for (int i = 0; i < 4; ++i) { a[i] = (v[8 * j + i] - mean) * rstd * g0[i] + b0[i]; b[i] = (v[8 * j + 4 + i] - mean) * rstd * g1[i] + b1[i]; }
        *(v4u*)(row + 512 * j + 8 * lane) = pack8(a, b);
        v2u o8; o8.x = pk4_fp8(a[0], a[1], a[2], a[3]); o8.y = pk4_fp8(b[0], b[1], b[2], b[3]); *(v2u*)(row8 + 512 * j + 8 * lane) = o8; }
}
__device__ __forceinline__ void p7_chunk(Frame& F, int ch, bf16* X1, const float* ln_g, const float* ln_b, const bf16* WR, const float* b_router, int* IDX, float* GW, int* RK, int* HIST) {
    const int lane = F.lane, w = F.wave, fr = lane & 15, fq = lane >> 4;
    const int t = ch * 128 + 16 * w + fr;
    f32x4 lg[4];
#pragma unroll
    for (int et = 0; et < 4; ++et) lg[et] = (f32x4){0.f, 0.f, 0.f, 0.f};
    const bf16* xrow = X1 + (size_t)t * D + 8 * fq;
    constexpr int WRS = 2064;
#pragma unroll 1
    for (int half = 0; half < 2; ++half) {
        if (half) __syncthreads();
        bf16x8 yc[8], yn[8];
#pragma unroll
        for (int ks = 0; ks < 8; ++ks) yc[ks] = *(const bf16x8*)(xrow + 1024 * half + 32 * ks);
#pragma unroll
        for (int kb = 0; kb < 2; ++kb) {
            v4u tmp[8];
#pragma unroll
            for (int k = 0; k < 8; ++k) { const int idx = F.tid + 512 * (kb * 8 + k), e = idx >> 7, c16 = idx & 127; tmp[k] = *(const v4u*)(WR + (size_t)e * D + 1024 * half + 8 * c16); }
#pragma unroll
            for (int k = 0; k < 8; ++k) { const int idx = F.tid + 512 * (kb * 8 + k), e = idx >> 7, c16 = idx & 127; *(LAS v4u*)(F.lds + RING_OFF + e * WRS + 16 * c16) = tmp[k]; }
        }
        __syncthreads();
        LAS const unsigned char* wl = F.lds + RING_OFF + fr * WRS + 16 * fq;
#pragma unroll
        for (int b = 0; b < 4; ++b) {
            if (b < 3) {
#pragma unroll
                for (int ks = 0; ks < 8; ++ks) yn[ks] = *(const bf16x8*)(xrow + 1024 * half + 32 * (8 * (b + 1) + ks));
            }
#pragma unroll
            for (int ks = 0; ks < 8; ++ks) {
#pragma unroll
                for (int et = 0; et < 4; ++et) { const bf16x8 xw = *(const LAS bf16x8*)(wl + (16 * et) * WRS + 64 * (8 * b + ks)); lg[et] = __builtin_amdgcn_mfma_f32_16x16x32_bf16(xw, yc[ks], lg[et], 0, 0, 0); }
            }
            __builtin_amdgcn_sched_barrier(0);
#pragma unroll
            for (int ks = 0; ks < 8; ++ks) yc[ks] = yn[ks];
        }
    }
    __syncthreads();
    float sc[16], sel[16];
#pragma unroll
    for (int et = 0; et < 4; ++et)
#pragma unroll
        for (int r = 0; r < 4; ++r) { float lgv = lg[et][r]; if (!(lgv == lgv)) lgv = 0.f; const float s = 1.0f / (1.0f + expf(-lgv)); sc[et * 4 + r] = s; sel[et * 4 + r] = s + b_router[16 * et + 4 * fq + r]; }
    int eidx[8]; float esc[8]; float ssum = 0.f;
#pragma unroll
    for (int k = 0; k < 8; ++k) {
        float best = -INFINITY; int bi = 0;
#pragma unroll
        for (int i = 0; i < 16; ++i) if (sel[i] > best) { best = sel[i]; bi = i; }
        int be = 16 * (bi >> 2) + 4 * fq + (bi & 3);
#pragma unroll
        for (int off = 16; off <= 32; off <<= 1) { const float ob = __shfl_xor(best, off); const int oe = __shfl_xor(be, off); if (ob > best || (ob == best && oe < be)) { best = ob; be = oe; } }
        const bool owner = ((be >> 2) & 3) == fq; const int li = (be >> 4) * 4 + (be & 3);
        float myv = 0.f;
#pragma unroll
        for (int i = 0; i < 16; ++i) if (owner && i == li) { myv = sc[i]; sel[i] = -INFINITY; }
        myv += __shfl_xor(myv, 16); myv += __shfl_xor(myv, 32);
        eidx[k] = be; esc[k] = myv; ssum += myv;
    }
    const float rn = 2.5f / ssum;
    LAS unsigned char* Etab = (LAS unsigned char*)(F.lds + RING_OFF);
    if (fq == 0) {
        *(int4*)(IDX + (size_t)t * 8) = make_int4(eidx[0], eidx[1], eidx[2], eidx[3]); *(int4*)(IDX + (size_t)t * 8 + 4) = make_int4(eidx[4], eidx[5], eidx[6], eidx[7]);
        *(f32x4*)(GW + (size_t)t * 8) = (f32x4){esc[0] * rn, esc[1] * rn, esc[2] * rn, esc[3] * rn}; *(f32x4*)(GW + (size_t)t * 8 + 4) = (f32x4){esc[4] * rn, esc[5] * rn, esc[6] * rn, esc[7] * rn};
        const unsigned lo = (unsigned)eidx[0] | ((unsigned)eidx[1] << 8) | ((unsigned)eidx[2] << 16) | ((unsigned)eidx[3] << 24), hi = (unsigned)eidx[4] | ((unsigned)eidx[5] << 8) | ((unsigned)eidx[6] << 16) | ((unsigned)eidx[7] << 24);
        *(LAS v2u*)(Etab + (16 * w + fr) * 8) = (v2u){lo, hi};
    }
    __syncthreads();
    int base[8];
#pragma unroll
    for (int ee = 0; ee < 8; ++ee) base[ee] = 0;
#pragma unroll
    for (int half = 0; half < 2; ++half) {
        const int tokl = half * 64 + lane; const v2u e8 = *(const LAS v2u*)(Etab + tokl * 8);
#pragma unroll
        for (int ee = 0; ee < 8; ++ee) {
            const unsigned e = (unsigned)(8 * w + ee); int kk = -1;
#pragma unroll
            for (int k = 0; k < 8; ++k) { const unsigned byte = ((k < 4 ? e8.x : e8.y) >> (8 * (k & 3))) & 0xffu; if (byte == e) kk = k; }
            const unsigned long long mask = __ballot(kk >= 0);
            const int below = __popcll(mask & ((1ull << lane) - 1ull));
            if (kk >= 0) RK[(size_t)(ch * 128 + tokl) * 8 + kk] = base[ee] + below;
            base[ee] += __popcll(mask);
        }
    }
    if (lane == 0) {
#pragma unroll
        for (int ee = 0; ee < 8; ++ee) HIST[ch * 64 + 8 * w + ee] = base[ee];
    }
    __syncthreads();
}
__device__ __forceinline__ void cv_item16(const float* W, int ldw, int n0, unsigned char* WT, size_t dstrow0, int ldk, int k0, int lane) {
    const int g = lane >> 4, c = lane & 15;
    const float* src = W + (size_t)(k0 + 16 * g) * ldw + n0 + 4 * c;
    f32x4 v[16];
#pragma unroll
    for (int kk = 0; kk < 16; ++kk) v[kk] = __builtin_nontemporal_load((const f32x4*)(src + (size_t)kk * ldw));
    unsigned char* dst = WT + (dstrow0 + 4 * c) * (size_t)ldk + k0 + 16 * g;
#pragma unroll
    for (int j = 0; j < 4; ++j) {
        v4u o; unsigned r;
#pragma unroll
        for (int q = 0; q < 4; ++q) {
            r = (unsigned)__builtin_amdgcn_cvt_pk_fp8_f32(v[4 * q][j] * W8_SCALE, v[4 * q + 1][j] * W8_SCALE, 0, false);
            r = (unsigned)__builtin_amdgcn_cvt_pk_fp8_f32(v[4 * q + 2][j] * W8_SCALE, v[4 * q + 3][j] * W8_SCALE, (int)r, true);
            o[q] = r;
        }
        *(v4u*)(dst + (size_t)j * ldk) = o;
    }
}
__device__ __forceinline__ void p7_convert_experts(Frame& F, const float* w_eg, const float* w_eu, const float* w_ed, const float* w_sg, const float* w_su, const float* w_sd) {
    const int gw = F.vcu * NWAVES + F.wave, NGW = F.G * NWAVES, lane = F.lane;
    unsigned char* WGU = F.ws + WS_WGU; unsigned char* WD = F.ws + WS_WD;
    for (int it = gw; it < 65 * 768; it += NGW) {
        const int e = it / 768, r = it % 768, which = r >> 8, q = r & 255;
        if (which < 2) {
            const float* src = (e < 64) ? ((which ? w_eu : w_eg) + (size_t)e * 2048 * 512) : (which ? w_su : w_sg);
            const int kb = q >> 3, nb = q & 7, n0 = 64 * nb;
            cv_item16(src, 512, n0, WGU, (size_t)e * 1024 + (size_t)((n0 >> 7) * 256 + (n0 & 127) + which * 128), 2048, kb * 64, lane);
        } else {
            const float* src = (e < 64) ? (w_ed + (size_t)e * 512 * 2048) : w_sd;
            const int kb = q >> 5, nb = q & 31;
            cv_item16(src, 2048, 64 * nb, WD, (size_t)e * 2048 + 64 * nb, 512, kb * 64, lane);
        }
    }
}
__device__ __forceinline__ void p8_sort(Frame& F, const int* HIST, const int* IDX, const float* GW, const int* RK, int* TOKSLOT, unsigned short* ROWTOK, float* ROWW, int* META, int* TILEE) {
    LAS int* cntl = (LAS int*)(F.lds + RING_OFF); LAS int* pst = cntl + 64; LAS int* basel = pst + 68; LAS int* part = basel + 64;
    { const int e = F.tid & 63, pq = F.tid >> 6; int s = 0;
#pragma unroll 8
      for (int c = 0; c < 32; ++c) s += HIST[(32 * pq + c) * 64 + e];
      part[pq * 64 + e] = s; }
    __syncthreads();
    if (F.tid < 64) { int s = 0;
#pragma unroll
        for (int pq = 0; pq < 8; ++pq) s += part[pq * 64 + F.tid];
        cntl[F.tid] = s; }
    __syncthreads();
    if (F.tid == 0) { int a = 0; for (int e = 0; e < 64; ++e) { pst[e] = a; a += (cntl[e] + 255) & ~255; } pst[64] = a; }
    __syncthreads();
    const int sh0 = pst[64], ntr = sh0 >> 8;
    for (int ch = blockIdx.x; ch < 256; ch += F.G) {
        if (F.tid < 64) { int s = 0; const int pfull = ch >> 5;
            for (int pq = 0; pq < pfull; ++pq) s += part[pq * 64 + F.tid];
            for (int c = pfull * 32; c < ch; ++c) s += HIST[c * 64 + F.tid];
            basel[F.tid] = s; }
        __syncthreads();
        for (int idx = F.tid; idx < 1024; idx += 512) {
            const size_t o = (size_t)(ch * 128) * 8 + idx; const int e = IDX[o] & 63; int slot = pst[e] + basel[e] + RK[o]; slot = slot < 0 ? 0 : (slot >= MAXTILES * 256 ? MAXTILES * 256 - 1 : slot);
            ROWTOK[slot] = (unsigned short)(ch * 128 + (idx >> 3)); ROWW[slot] = GW[o]; TOKSLOT[o] = slot;
        }
        __syncthreads();
    }
    for (int e = blockIdx.x; e < 64; e += F.G) for (int s = pst[e] + cntl[e] + F.tid; s < pst[e + 1]; s += 512) { ROWTOK[s] = 0; ROWW[s] = 0.f; }
    for (int t = blockIdx.x * 512 + F.tid; t < T; t += F.G * 512) { ROWTOK[sh0 + t] = (unsigned short)t; ROWW[sh0 + t] = 1.0f; }
    if (blockIdx.x == 0) {
        if (F.tid == 0) { META[0] = ntr; META[1] = ntr + T / 256; META[2] = sh0; }
        for (int j = F.tid; j < ntr + T / 256; j += 512) { int e = 64; if (j < ntr) { e = 0; for (int k = 0; k < 64; ++k) if (pst[k + 1] <= j * 256) e = k + 1; } TILEE[j] = e; }
    }
    __syncthreads();
}
__device__ __forceinline__ int moe_tables(Frame& F, int shift, bool tokens, const int* META, const int* TILEE, const unsigned short* ROWTOK) {
    LAS int* etab = (LAS int*)(F.lds + ETAB_OFF); LAS unsigned short* tok = (LAS unsigned short*)(F.lds + TOKTAB_OFF);
    const int ntiles = __builtin_amdgcn_readfirstlane(META[1]);
    for (int i = F.tid; i < 64; i += 512) { const int j = (i * F.G + F.vcu) >> shift; etab[i] = (j < ntiles) ? TILEE[j] : 0; }
    if (tokens) for (int x = F.tid; x < 20 * 256; x += 512) { const int i = x >> 8, j = (i * F.G + F.vcu) >> 2; tok[x] = (j < ntiles) ? ROWTOK[(size_t)j * 256 + (x & 255)] : (unsigned short)0; }
    __syncthreads();
    return ntiles;
}
__device__ __forceinline__ void dec16(v4u w, float (&o)[16]) {
    const unsigned ws_[4] = {w.x, w.y, w.z, w.w};
#pragma unroll
    for (int k = 0; k < 4; ++k) { const f32x2 a = __builtin_amdgcn_cvt_pk_f32_fp8((int)ws_[k], false), b = __builtin_amdgcn_cvt_pk_f32_fp8((int)ws_[k], true); o[4 * k] = a[0]; o[4 * k + 1] = a[1]; o[4 * k + 2] = b[0]; o[4 * k + 3] = b[1]; }
}
__device__ __forceinline__ void combine_chunk(Frame& F, int cc, const bf16* X1, const unsigned char* Y, const int* TOKSLOT, const int* META, bf16* PRE2, const float* ln_g, const float* ln_b) {
    unsigned char* const x28 = F.ws + WS_X8;
    const int gw = F.vcu * NWAVES + F.wave, NGW = F.G * NWAVES, lane = F.lane;
    const int sh0 = __builtin_amdgcn_readfirstlane(META[2]);
    LAS float* lgb = (LAS float*)(F.lds + RING_OFF);
    if (cc == 1) { for (int i = F.tid; i < 2048; i += 512) { lgb[i] = ln_g[i]; lgb[2048 + i] = ln_b[i]; } __syncthreads(); }
    int t = gw;
    int tn = t + NGW;
    int slot_c = TOKSLOT[(size_t)t * 8 + (lane & 7)];
    int slot_n = TOKSLOT[(size_t)(tn < T ? tn : t) * 8 + (lane & 7)];
    v4u yv[9], xa, xb, w0 = (v4u){0, 0, 0, 0}, w1 = (v4u){0, 0, 0, 0};
#define CMB_LOAD(tt, sl, YV, XA, XB, W0, W1) do { \
        _Pragma("unroll") for (int k = 0; k < 8; ++k) { const int slot = __shfl(sl, k); YV[k] = __builtin_nontemporal_load((const v4u*)(Y + (size_t)slot * 1024 + 16 * lane)); } \
        YV[8] = __builtin_nontemporal_load((const v4u*)(Y + (size_t)(sh0 + (tt)) * 1024 + 16 * lane)); \
        { const bf16* xr = X1 + (size_t)(tt) * D + 1024 * cc + 16 * lane; XA = *(const v4u*)xr; XB = *(const v4u*)(xr + 8); } \
        if (cc == 1) { const bf16* pq = PRE2 + (size_t)(tt) * D + 16 * lane; W0 = __builtin_nontemporal_load((const v4u*)pq); W1 = __builtin_nontemporal_load((const v4u*)(pq + 8)); } } while (0)
#define CMB_BODY(tt, YV, XA, XB, W0, W1) do { \
        float a[16]; \
        { f32x4 p, q; unpack8(XA, p, q); \
          _Pragma("unroll") for (int i = 0; i < 4; ++i) { a[i] = p[i] * ALPHA; a[4 + i] = q[i] * ALPHA; } \
          unpack8(XB, p, q); \
          _Pragma("unroll") for (int i = 0; i < 4; ++i) { a[8 + i] = p[i] * ALPHA; a[12 + i] = q[i] * ALPHA; } } \
        float ys[16]; \
        _Pragma("unroll") for (int i = 0; i < 16; ++i) ys[i] = 0.f; \
        _Pragma("unroll") for (int k = 0; k < 9; ++k) { float y[16]; dec16(YV[k], y); \
            _Pragma("unroll") for (int i = 0; i < 16; ++i) ys[i] += y[i]; } \
        _Pragma("unroll") for (int i = 0; i < 16; ++i) a[i] += ys[i] * (1.0f / Y8_SCALE); \
        bf16* pr = PRE2 + (size_t)(tt) * D + 16 * lane; \
        if (cc == 0) { \
            v4u o0, o1; o0.x = pk2(a[0], a[1]); o0.y = pk2(a[2], a[3]); o0.z = pk2(a[4], a[5]); o0.w = pk2(a[6], a[7]); o1.x = pk2(a[8], a[9]); o1.y = pk2(a[10], a[11]); o1.z = pk2(a[12], a[13]); o1.w = pk2(a[14], a[15]); \
            *(v4u*)pr = o0; *(v4u*)(pr + 8) = o1; \
        } else { \
            float v[32]; \
            { f32x4 p, q; unpack8(W0, p, q); \
              _Pragma("unroll") for (int i = 0; i < 4; ++i) { v[i] = p[i]; v[4 + i] = q[i]; } \
              unpack8(W1, p, q); \
              _Pragma("unroll") for (int i = 0; i < 4; ++i) { v[8 + i] = p[i]; v[12 + i] = q[i]; } } \
            _Pragma("unroll") for (int i = 0; i < 16; ++i) v[16 + i] = a[i]; \
            float mean, rstd; ln_stats32(v, mean, rstd); \
            _Pragma("unroll") for (int j = 0; j < 2; ++j) { \
                float o[16]; \
                _Pragma("unroll") for (int q4 = 0; q4 < 4; ++q4) { const f32x4 g4 = *(const LAS f32x4*)(lgb + 1024 * j + 16 * lane + 4 * q4), b4 = *(const LAS f32x4*)(lgb + 2048 + 1024 * j + 16 * lane + 4 * q4); \
                    _Pragma("unroll") for (int i = 0; i < 4; ++i) o[4 * q4 + i] = (v[16 * j + 4 * q4 + i] - mean) * rstd * g4[i] + b4[i]; } \
                v4u o0, o1; o0.x = pk2(o[0], o[1]); o0.y = pk2(o[2], o[3]); o0.z = pk2(o[4], o[5]); o0.w = pk2(o[6], o[7]); o1.x = pk2(o[8], o[9]); o1.y = pk2(o[10], o[11]); o1.z = pk2(o[12], o[13]); o1.w = pk2(o[14], o[15]); \
                *(v4u*)(pr + 1024 * j) = o0; *(v4u*)(pr + 1024 * j + 8) = o1; \
                if (FP8_P14) { v4u o8; o8.x = pk4_fp8(o[0], o[1], o[2], o[3]); o8.y = pk4_fp8(o[4], o[5], o[6], o[7]); o8.z = pk4_fp8(o[8], o[9], o[10], o[11]); o8.w = pk4_fp8(o[12], o[13], o[14], o[15]); *(v4u*)(x28 + (size_t)(tt) * D + 1024 * j + 16 * lane) = o8; } \
            } \
        } } while (0)
    v4u yb[9], xc, xd, w2 = (v4u){0, 0, 0, 0}, w3 = (v4u){0, 0, 0, 0};
    CMB_LOAD(t, slot_c, yv, xa, xb, w0, w1);
    __builtin_amdgcn_s_waitcnt(0x0F70);
    for (;;) {
        const int t2 = tn + NGW;
        const int slot_2 = TOKSLOT[(size_t)(t2 < T ? t2 : t) * 8 + (lane & 7)];
        __builtin_amdgcn_sched_barrier(0);
        CMB_LOAD((tn < T ? tn : t), slot_n, yb, xc, xd, w2, w3);
        __builtin_amdgcn_sched_barrier(0);
        CMB_BODY(t, yv, xa, xb, w0, w1);
        if (tn >= T) break;
        const int t3 = t2 + NGW;
        const int slot_3 = TOKSLOT[(size_t)(t3 < T ? t3 : t) * 8 + (lane & 7)];
        __builtin_amdgcn_sched_barrier(0);
        CMB_LOAD((t2 < T ? t2 : t), slot_2, yv, xa, xb, w0, w1);
        __builtin_amdgcn_sched_barrier(0);
        CMB_BODY(tn, yb, xc, xd, w2, w3);
        if (t2 >= T) break;
        t = t2; tn = t3; slot_n = slot_3;
    }
#undef CMB_BODY
#undef CMB_LOAD
    if (cc == 1) __syncthreads();
}
__device__ __forceinline__ void final_ln(Frame& F, const bf16* PRE3, const float* ln_g, const float* ln_b, float* out) {
    const int gw = F.vcu * NWAVES + F.wave, NGW = F.G * NWAVES, lane = F.lane;
    for (int t0 = gw * 2; t0 < T; t0 += NGW * 2) {
        v4u rw[2][4];
#pragma unroll
        for (int r = 0; r < 2; ++r)
#pragma unroll
            for (int j = 0; j < 4; ++j) rw[r][j] = *(const v4u*)(PRE3 + (size_t)(t0 + r) * D + 512 * j + 8 * lane);
        ln_multi<2>(rw, ln_g, ln_b, lane, [&](int r, int j, const f32x4& a, const f32x4& b) {
            float* o = out + (size_t)(t0 + r) * D + 512 * j + 8 * lane; *(f32x4*)o = a; *(f32x4*)(o + 4) = b; });
    }
}


__device__ __forceinline__ const float* ld_in(int k) {
#if defined(__HIP_DEVICE_COMPILE__)
    auto ka = __builtin_amdgcn_kernarg_segment_ptr(); unsigned long long v;
    asm volatile("s_load_dwordx2 %0, %1, %2\n\ts_waitcnt lgkmcnt(0)" : "=s"(v) : "s"(ka), "s"(k * 8) : "memory");
    return (const float*)(const GAS float*)v;
#else
    return nullptr;
#endif
}

constexpr int CW_BAD = 8;
__device__ __forceinline__ void chk_bf16(Frame& F, const bf16* p, size_t n, int id, unsigned* ctl) {
    bool bad = false;
    for (size_t i = ((size_t)blockIdx.x * 512 + F.tid) * 8; i < n; i += (size_t)F.G * 512 * 8) { const v4u w = *(const v4u*)(p + i);
        const unsigned ws_[4] = {w.x, w.y, w.z, w.w};
#pragma unroll
        for (int k = 0; k < 4; ++k) { if ((ws_[k] & 0x7f80u) == 0x7f80u || (ws_[k] & 0x7f800000u) == 0x7f800000u) bad = true; } }
    if (bad) atomicMax(ctl + CW_BAD, (unsigned)(64 - id));
}
__device__ __forceinline__ void chk_f32(Frame& F, const float* p, size_t n, int id, unsigned* ctl) {
    bool bad = false;
    for (size_t i = (size_t)blockIdx.x * 512 + F.tid; i < n; i += (size_t)F.G * 512) { if ((__float_as_uint(p[i]) & 0x7f800000u) == 0x7f800000u) bad = true; }
    if (bad) atomicMax(ctl + CW_BAD, (unsigned)(64 - id));
}
constexpr int NPHASE = 15;
struct Args { const float* in[28]; float* out; unsigned char* ws; int ph_lo, ph_hi, flags, pad; };
__global__ void __launch_bounds__(NWAVES * 64, 2) fwd(Args args) {
    extern __shared__ __attribute__((aligned(16))) unsigned char lds[];
    Frame F;
    F.lds = (LAS unsigned char*)lds;
    F.tid = threadIdx.x; F.lane = F.tid & 63; F.wave = __builtin_amdgcn_readfirstlane(F.tid >> 6);
    F.G = gridDim.x; { const int bx = blockIdx.x; F.vcu = (F.G % 8 == 0) ? (bx % 8) * (F.G / 8) + bx / 8 : bx; }
    F.ws = args.ws;
    unsigned char* ws = args.ws;
    unsigned* ctl = (unsigned*)(ws + WS_CTL);
    for (int u = F.tid; u < (LDS_BYTES - LDSCTL_OFF) / 4; u += NWAVES * 64) ((LAS unsigned*)(F.lds + LDSCTL_OFF))[u] = 0u;
    __syncthreads();
    const int lo = args.ph_lo, hi = args.ph_hi;
    XcdBarrier bar = xcd_barrier_post(ctl + CW_BAR + lo * XCD_BAR_WORDS, (volatile LAS unsigned*)(F.lds + MISC_OFF));
#ifdef PH_ONLY
#define PH_EN(k) ((k) == PH_ONLY)
#elif defined(PH_MASK)
#define PH_EN(k) (((PH_MASK) >> (k)) & 1)
#else
#define PH_EN(k) 1
#endif
#define IN(k) (PH_EN(k) && lo <= (k) && (k) < hi)
#define SEAM(k) do { if (IN(k) && IN((k) + 1)) xcd_barrier(bar); } while (0)
#define FRESH() do { int t_ = threadIdx.x; asm volatile("" : "+v"(t_)); F.tid = t_; F.lane = t_ & 63; F.wave = __builtin_amdgcn_readfirstlane(t_ >> 6); } while (0)
    bf16* const Hb = (bf16*)(ws + WS_H); bf16* const MG = (bf16*)(ws + WS_MG); bf16* const PROJ = (bf16*)(ws + WS_PROJ); bf16* const DC = (bf16*)(ws + WS_DC);
    float* const GIF = (float*)(ws + WS_GIF); float* const SC = (float*)(ws + WS_SC); float* const MS = (float*)(ws + WS_MS); float* const DN = (float*)(ws + WS_DN); float* const NST = (float*)(ws + WS_NST);
    int* const IDX = (int*)(ws + WS_IDX); float* const GW = (float*)(ws + WS_GW); int* const RK = (int*)(ws + WS_RK); int* const TOKSLOT = (int*)(ws + WS_TOKSLOT); int* const HIST = (int*)(ws + WS_HIST);
    int* const META = (int*)(ws + WS_META); int* const TILEE = (int*)(ws + WS_TILEE); unsigned short* const ROWTOK = (unsigned short*)(ws + WS_ROWTOK); float* const ROWW = (float*)(ws + WS_ROWW);
    unsigned char* const HB = ws + WS_HB; bf16* const Y = (bf16*)(ws + WS_Y); bf16* const PPB = (bf16*)(ws + WS_PPB);
    LAS unsigned char* const ring = F.lds + RING_OFF;
    LAS const unsigned short* const toktab = (LAS const unsigned short*)(F.lds + TOKTAB_OFF);
    LAS const int* const etab = (LAS const int*)(F.lds + ETAB_OFF);

    FRESH();
    if (IN(0)) p0_prologue(F, ld_in(0), ld_in(1), ld_in(2), ld_in(3), ld_in(4), ld_in(9), ld_in(10), ld_in(11), ld_in(14), ld_in(24), ld_in(25));
    SEAM(0);
#ifdef DBG_CHK
    if (IN(1)) { chk_bf16(F, Hb, (size_t)T * D, 1, ctl); chk_f32(F, GIF, (size_t)T * 8, 2, ctl); chk_bf16(F, (const bf16*)(ws + WS_WIN), (size_t)NPROJ * D, 3, ctl); }
#endif
    FRESH();
    if (IN(1)) {
        constexpr int eb = FP8_P1 ? 1 : 2;
        SchedDense S; S.o.init(T / 256, NPROJ / 256, F.G, (int)blockIdx.x); S.A = FP8_P1 ? (const char*)(ws + WS_H8) : (const char*)Hb; S.B = (const char*)(ws + WS_WIN); S.ta = (size_t)256 * D * eb; S.tb = (size_t)256 * D * eb;
        EpiProj E{PROJ};
        pg8::gemm_phase<EpiProj, SchedDense, false, true, FP8_P1 != 0>(ring, D * eb, D * eb, D * eb / 128, S, E, toktab, 127 - 6);
    }
    SEAM(1);
#ifdef DBG_CHK
    if (IN(2)) { chk_bf16(F, PROJ, (size_t)T * NPROJ, 4, ctl); }
#endif
    FRESH();
    if (IN(2)) {
        if (!(args.flags & 2)) for (int u = blockIdx.x; u < 512; u += F.G) attn_unit(F, u, PROJ, ld_in(5));
#ifndef DBG_NO_MLA
        for (int u = blockIdx.x; u < 2048; u += F.G) mlstm_a_unit(F, u, PROJ, GIF, ld_in(6), ld_in(7), DC, SC, DN);
#endif
    }
    SEAM(2);
#ifdef DBG_CHK
    if (IN(3)) { chk_bf16(F, PROJ, (size_t)T * NPROJ, 5, ctl); chk_bf16(F, DC, (size_t)2048 * 32768, 6, ctl); chk_f32(F, SC, 4096, 7, ctl); chk_f32(F, DN, 2048 * 128, 8, ctl); }
#endif
    FRESH();
    if (IN(3)) mlstm_scan(F, DC, SC, DN, NST, MS);
    SEAM(3);
#ifdef DBG_CHK
    if (IN(4)) { chk_bf16(F, DC, (size_t)2048 * 32768, 9, ctl); chk_f32(F, NST, 2048 * 128, 10, ctl); chk_f32(F, MS, 2048, 11, ctl); }
#endif
    FRESH();
    if (IN(4)) {
        v4u ctr[8], vvr[4];
        if ((int)blockIdx.x < 2048) mlstm_c_preload(F, blockIdx.x, PROJ, DC, ctr, vvr);
        for (int u = blockIdx.x; u < 2048; u += F.G) mlstm_c_unit(F, u, (u + F.G < 2048) ? u + F.G : -1, ctr, vvr, PROJ, GIF, ld_in(6), ld_in(7), DC, NST, MS, ld_in(8));
    }
    SEAM(4);
#ifdef DBG_CHK
    if (IN(5)) { chk_bf16(F, PROJ, (size_t)T * NPROJ, 12, ctl); }
#endif
    FRESH();
    if (IN(5)) {
        SchedMerge S; S.o.init(T / 256, D / 256, F.G, (int)blockIdx.x); S.A0 = (const char*)PSEG(PROJ, C_Q); S.A1 = (const char*)PSEG(PROJ, C_MV); S.B0 = (const char*)(ws + WS_WBA); S.B1 = (const char*)(ws + WS_WBM);
        S.ta = (size_t)256 * 1024 * 2; S.tb = (size_t)256 * 1024 * 2; S.cnt = 2;
        EpiMerge E{PROJ, MG};
        const int ntile = (T / 256) * (D / 256) / F.G > 0 ? (T / 256) * (D / 256) / F.G + (((T / 256) * (D / 256)) % F.G ? 1 : 0) : 1;
        const int cls = F.vcu % ntile;
        for (int k = 0; k < ntile; ++k) {
            if (k == cls) { p7_convert_experts(F, ld_in(16), ld_in(17), ld_in(18), ld_in(19), ld_in(20), ld_in(21)); __syncthreads(); }
            S.base = 2 * k;
            pg8::gemm_phase<EpiMerge, SchedMerge, false, true>(ring, 1024 * 2, 1024 * 2, 1024 / 64, S, E, toktab);
        }
    }
    SEAM(5);
#ifdef DBG_CHK
    if (IN(6)) { chk_bf16(F, MG, (size_t)T * D, 13, ctl); }
#endif
    FRESH();
    if (IN(6)) {
        constexpr int eb = FP8_P6 ? 1 : 2;
        const int ncall = ((T / 256) * (D / 256) + F.G - 1) / F.G;
        for (int k = 0; k < ncall; ++k) {
            SchedPanel S{F.G, F.vcu, k, T / 256, (const char*)MG, (const char*)(ws + WS_WOUT), (size_t)256 * D * eb, (size_t)256 * D * eb};
            EpiResidLn E{Hb, ws + WS_X8, ld_in(12), ld_in(13), (unsigned long long*)(ws + WS_LNX2) + (size_t)k * (T / 256) * 256 * 8, ctl + CW_LN2 + k * (T / 256) * 64};
            pg8::gemm_phase<EpiResidLn, SchedPanel, false, false, FP8_P6 != 0>(ring, D * eb, D * eb, D * eb / 128, S, E, toktab, 127 - 9);
        }
    }
    SEAM(6);
#ifdef DBG_CHK
    if (IN(7)) { chk_bf16(F, Hb, (size_t)T * D, 14, ctl); }
#endif
    FRESH();
    if (IN(7)) {
        for (int ch = blockIdx.x; ch < 256; ch += F.G) p7_chunk(F, ch, Hb, ld_in(12), ld_in(13), (const bf16*)(ws + WS_WR), ld_in(15), IDX, GW, RK, HIST);
    }
    SEAM(7);
#ifdef DBG_CHK
    if (IN(8)) { chk_bf16(F, Hb, (size_t)T * D, 15, ctl); chk_f32(F, GW, (size_t)T * 8, 16, ctl);  }
#endif
    FRESH();
    if (IN(8)) p8_sort(F, HIST, IDX, GW, RK, TOKSLOT, ROWTOK, ROWW, META, TILEE);
    SEAM(8);
    FRESH();
    if (IN(9)) {
        const int ntiles = moe_tables(F, 2, true, META, TILEE, ROWTOK);
        SchedGU S{F.G, F.vcu, ntiles, (const char*)(ws + WS_X8), (const char*)(ws + WS_WGU), etab};
        EpiGU E{HB, ROWW};
        pg8::gemm_phase<EpiGU, SchedGU, true, true, true>(ring, D, D, D / 128, S, E, toktab, 127 - 6);
    }
    SEAM(9);
#ifdef DBG_CHK

#endif
    unsigned char* const Y8 = ws + WS_Y;
    for (int c = 0; c < 2; ++c) {
        FRESH();
        if (IN(10 + 2 * c)) {
            const int ntiles = moe_tables(F, 2, false, META, TILEE, ROWTOK);
            SchedDown S{F.G, F.vcu, ntiles, c, (const char*)HB, (const char*)(ws + WS_WD), etab};
            EpiStore8 E{Y8, 1024};
            int nt_dn = DE / 128; asm volatile("" : "+s"(nt_dn));
            pg8::gemm_phase<EpiStore8, SchedDown, false, false, true>(ring, DE, DE, nt_dn, S, E, toktab, 127 - 4);
        }
        SEAM(10 + 2 * c);
        FRESH();
        if (IN(11 + 2 * c)) combine_chunk(F, c, Hb, Y8, TOKSLOT, META, MG, ld_in(22), ld_in(23));
        if (c < 1) SEAM(11 + 2 * c);
    }
    FRESH();
    if (IN(13)) {
        SchedDense S; S.o.init(T / 256, D / 256, F.G, (int)blockIdx.x); S.A = (const char*)(ws + WS_PB); S.B = (const char*)(ws + WS_WPP); S.ta = (size_t)256 * 256 * 2; S.tb = (size_t)256 * 256 * 2;
        EpiStore E{PPB, D, 1.0f};
        int nt_pp = 256 / 64; asm volatile("" : "+s"(nt_pp));
        pg8::gemm_phase<EpiStore, SchedDense, false, true>(ring, 256 * 2, 256 * 2, nt_pp, S, E, toktab);
    }
    SEAM(13);
    FRESH();
    if (IN(14)) {
        constexpr int eb = FP8_P14 ? 1 : 2;
        const int ncall = ((T / 256) * (D / 256) + F.G - 1) / F.G;
        for (int k = 0; k < ncall; ++k) {
            SchedPanel S{F.G, F.vcu, k, T / 256, FP8_P14 ? (const char*)(ws + WS_X8) : (const char*)MG, (const char*)(ws + WS_WPG), (size_t)256 * D * eb, (size_t)256 * D * eb};
            EpiPleLn E{MG, PPB, args.out, ld_in(26), ld_in(27), (unsigned long long*)(ws + WS_LNX) + (size_t)k * (T / 256) * 256 * 8, ctl + CW_LN + k * (T / 256) * 64};
            pg8::gemm_phase<EpiPleLn, SchedPanel, false, false, FP8_P14 != 0>(ring, D * eb, D * eb, D * eb / 128, S, E, toktab, 127 - 6);
        }
    }
#undef IN
#undef SEAM
}

#ifndef MK_PER_PHASE
#define MK_PER_PHASE 0
#endif
#ifndef MK_MAXPH
#define MK_MAXPH 15
#endif
extern "C" void kernel_launch(void* const* d_in, const int* in_sizes, int n_in, void* d_out, int out_size, void* d_ws, size_t ws_size, hipStream_t stream) {
    static int grid = 0;
    if (grid == 0) {
        if (n_in != 28 || out_size != T * D || ws_size < WS_END) { fprintf(stderr, "kernel_launch: unexpected problem (n_in %d out %d ws %zu)\n", n_in, out_size, ws_size); grid = -1; return; }
        int dev = 0, cus = 0;
        if (hipGetDevice(&dev) != hipSuccess || hipDeviceGetAttribute(&cus, hipDeviceAttributeMultiprocessorCount, dev) != hipSuccess) { grid = -1; return; }
        if (hipFuncSetAttribute((const void*)fwd, hipFuncAttributeMaxDynamicSharedMemorySize, LDS_BYTES) != hipSuccess) { grid = -1; return; }
        int per_cu = 0;
        (void)hipOccupancyMaxActiveBlocksPerMultiprocessor(&per_cu, (const void*)fwd, NWAVES * 64, LDS_BYTES);
        (void)hipGetLastError();
        grid = cus;
    }
    if (grid < 0) return;
    if (hipMemsetAsync((char*)d_ws + WS_CTL, 0, CTL_ZERO_BYTES, stream) != hipSuccess) return;
    Args a{};
    for (int i = 0; i < 28; ++i) a.in[i] = (const float*)d_in[i];
    a.out = (float*)d_out; a.ws = (unsigned char*)d_ws;
#if MK_PER_PHASE
#ifdef DBG_DUMP
    for (int ph = 0; ph <= DBG_DUMP; ++ph) { a.ph_lo = ph; a.ph_hi = ph + 1; hipLaunchKernelGGL(fwd, dim3(grid), dim3(NWAVES * 64), LDS_BYTES, stream, a); }
    a.ph_lo = 15; a.ph_hi = 16; hipLaunchKernelGGL(fwd, dim3(grid), dim3(NWAVES * 64), LDS_BYTES, stream, a);
#else
    for (int ph = 0; ph < MK_MAXPH; ++ph) { a.ph_lo = ph; a.ph_hi = ph + 1; hipLaunchKernelGGL(fwd, dim3(grid), dim3(NWAVES * 64), LDS_BYTES, stream, a); }
#endif
#else
    a.ph_lo = 0; a.ph_hi = NPHASE; hipLaunchKernelGGL(fwd, dim3(grid), dim3(NWAVES * 64), LDS_BYTES, stream, a);
#ifdef PROBE_PH
    a.ph_lo = PROBE_PH; a.ph_hi = PROBE_PH + 1; a.flags = PROBE_FLAGS; hipLaunchKernelGGL(fwd, dim3(grid), dim3(NWAVES * 64), LDS_BYTES, stream, a);
#endif
#endif
}
```

```cpp
#include <hip/hip_runtime.h>
#ifndef FP8_P1
#define FP8_P1 1
#endif
#ifndef FP8_P6
#define FP8_P6 1
#endif
#ifndef FP8_P14
#define FP8_P14 1
#endif
#include <cstdio>
#include <cstdint>
#include <type_traits>

#define GAS __attribute__((address_space(1)))
#define LAS __attribute__((address_space(3)))
typedef unsigned short bf16;
typedef unsigned v4u __attribute__((ext_vector_type(4)));
typedef unsigned v2u __attribute__((ext_vector_type(2)));
typedef float f32x4 __attribute__((ext_vector_type(4)));
typedef float f32x2 __attribute__((ext_vector_type(2)));
typedef short bf16x8 __attribute__((ext_vector_type(8)));
typedef short bf16x4 __attribute__((ext_vector_type(4)));

constexpr int T = 32768, D = 2048, SEQ = 16384;
constexpr int NPROJ = 8448;
constexpr int C_Q = 0, C_K = 1024, C_V = 1152, C_MQ = 1280, C_MK = 1792, C_MV = 2304, C_MO = 3328, C_GA = 4352, C_GB = 6400;
constexpr int WIN_LD = 8456;
#define PSEG(P, C) ((P) + (size_t)T * (C))
constexpr int NEXP = 64, TOPK = 8, DE = 512;
constexpr int MAXTILES = (T * TOPK) / 256 + NEXP + T / 256;
constexpr float LOG2E = 1.4426950408889634f;
constexpr float ALPHA = 1.189207115002721f;
constexpr float LN_EPS = 1e-5f, RMS_EPS = 1e-6f;

constexpr size_t MiB = 1u << 20;
constexpr size_t WS_CTL = 0, CTL_ZERO_BYTES = 1 * MiB;
constexpr size_t WS_GIF = 1 * MiB;
constexpr size_t WS_SC = 2 * MiB;
constexpr size_t WS_MS = 2 * MiB + 256 * 1024;
constexpr size_t WS_DN = 3 * MiB;
constexpr size_t WS_NST = 4 * MiB;
constexpr size_t WS_IDX = 5 * MiB;
constexpr size_t WS_GW = 6 * MiB;
constexpr size_t WS_RK = 7 * MiB;
constexpr size_t WS_TOKSLOT = 8 * MiB;
constexpr size_t WS_HIST = 9 * MiB;
constexpr size_t WS_META = 9 * MiB + 256 * 1024;
constexpr size_t WS_TILEE = 9 * MiB + 512 * 1024;
constexpr size_t WS_ROWTOK = 10 * MiB;
constexpr size_t WS_ROWW = 11 * MiB;
constexpr size_t WS_WIN = 16 * MiB;
constexpr size_t WS_WBA = 49 * MiB;
constexpr size_t WS_WBM = 53 * MiB;
constexpr size_t WS_WOUT = 57 * MiB;
constexpr size_t WS_WR = 65 * MiB;
constexpr size_t WS_WPP = 66 * MiB;
constexpr size_t WS_WPG = 67 * MiB;
constexpr size_t WS_PB = 75 * MiB;
constexpr size_t WS_H = 92 * MiB;
constexpr size_t WS_MG = 220 * MiB;
constexpr size_t WS_PROJ = 348 * MiB;
constexpr size_t WS_DC = 876 * MiB;
constexpr size_t WS_X8 = 348 * MiB;
constexpr size_t WS_HB = 412 * MiB;
constexpr size_t WS_PPB = 412 * MiB;
constexpr size_t WS_Y = 564 * MiB;
constexpr size_t WS_WGU = 876 * MiB;
constexpr size_t WS_WD = 1006 * MiB;
constexpr size_t WS_LNX = 1136 * MiB;
constexpr size_t WS_LNX2 = 1144 * MiB;
constexpr size_t WS_END = 1152 * MiB;
constexpr float W8_SCALE = 64.0f, HB8_SCALE = 4.0f, Y8_SCALE = 16.0f, MG8_SCALE = 8.0f;
constexpr size_t WS_H8 = 1004 * MiB;

constexpr int CW_TMO = 0;
constexpr int CW_BAR = 4096;
constexpr int CW_LN2 = 65536 + 32768;
constexpr int CW_LN = 65536;

constexpr int RING_OFF = 0, RING_BYTES = 131072;
constexpr int TOKTAB_OFF = RING_BYTES;
constexpr int ETAB_OFF = TOKTAB_OFF + 10240;
constexpr int LDSCTL_OFF = ETAB_OFF + 256, MISC_OFF = LDSCTL_OFF + 64;
constexpr int LDS_BYTES = 147456;
static_assert(MISC_OFF + 128 <= LDS_BYTES, "LDS map");

#define RLX_AGENT __ATOMIC_RELAXED, __HIP_MEMORY_SCOPE_AGENT
#define LDS_WAIT() asm volatile("s_waitcnt lgkmcnt(0)" ::: "memory")
#define VM_WAIT() asm volatile("s_waitcnt vmcnt(0)" ::: "memory")
#define LBAR() do { asm volatile("s_waitcnt lgkmcnt(0)" ::: "memory"); __builtin_amdgcn_s_barrier(); asm volatile("" ::: "memory"); } while (0)

__device__ __forceinline__ float bflo(unsigned u) { return __uint_as_float(u << 16); }
__device__ __forceinline__ float bfhi(unsigned u) { return __uint_as_float(u & 0xffff0000u); }
__device__ __forceinline__ float bf2f(unsigned short b) { return __uint_as_float(((unsigned)b) << 16); }
typedef __bf16 bf16x2_t __attribute__((ext_vector_type(2)));
__device__ __forceinline__ unsigned pk2(float lo, float hi) { f32x2 f = {lo, hi}; return __builtin_bit_cast(unsigned, __builtin_convertvector(f, bf16x2_t)); }
__device__ __forceinline__ unsigned f2bf(float f) { return pk2(f, 0.f) & 0xffffu; }
typedef int v8i __attribute__((ext_vector_type(8)));
typedef int v4i __attribute__((ext_vector_type(4)));
__device__ __forceinline__ float clamp8(float x) { return __builtin_amdgcn_fmed3f(x, -448.0f, 448.0f); }
__device__ __forceinline__ unsigned pk4_fp8(float a, float b, float c, float d) {
    unsigned r = (unsigned)__builtin_amdgcn_cvt_pk_fp8_f32(clamp8(a), clamp8(b), 0, false); return (unsigned)__builtin_amdgcn_cvt_pk_fp8_f32(clamp8(c), clamp8(d), (int)r, true); }
__device__ __forceinline__ float fast_exp2(float x) { return __builtin_amdgcn_exp2f(x); }
__device__ __forceinline__ float fast_rcp(float x) { return __builtin_amdgcn_rcpf(x); }
__device__ __forceinline__ float sigmoidf_(float v) { return fast_rcp(1.0f + fast_exp2(-v * LOG2E)); }
__device__ __forceinline__ float wave_sum(float v) {
#pragma unroll
    for (int o = 1; o < 64; o <<= 1) v += __shfl_xor(v, o);
    return v;
}
__device__ __forceinline__ float wave_max(float v) {
#pragma unroll
    for (int o = 1; o < 64; o <<= 1) v = fmaxf(v, __shfl_xor(v, o));
    return v;
}

__device__ __forceinline__ f32x4 zero_acc() { f32x4 z = (f32x4){0.f, 0.f, 0.f, 0.f}; asm volatile("" : "+v"(z)); return z; }
namespace pg8 {
template <class T, class = void> struct after_drain : std::false_type {};
template <class T> struct after_drain<T, std::void_t<decltype(T::AFTER_DRAIN)>> : std::bool_constant<T::AFTER_DRAIN> {};
constexpr int BM = 256, BK = 64, HALF = 128, HTB = HALF * BK * 2, STAGE_BYTES = 8 * HTB;
__host__ __device__ __forceinline__ int lds_byte(int r, int c) { const int st = (r >> 4) * 2 + (c >> 5), rr = r & 15, cc = c & 31, ob = rr * 64 + cc * 2; return st * 1024 + (ob ^ (((ob >> 9) & 1) << 5)); }
__host__ __device__ __forceinline__ void stage_rc(int b, int& R, int& C) { const int st = b / 1024, sb = b % 1024, swz = sb ^ (((sb >> 9) & 1) << 5); R = (st >> 1) * 16 + swz / 64; C = (st & 1) * 32 + (swz % 64) / 2; }
__host__ __device__ __forceinline__ int perm32(int rho) { const int n = rho >> 4, i = rho & 15; return 8 * (i >> 2) + 4 * n + (i & 3); }

struct UnitD { const char* A; const char* B; int pm, pn, aux, slot; };

struct DenseOrder {
    int nM, nN, nwg, G, c;
    __device__ void init(int nM_, int nN_, int G_, int c_) { nM = nM_; nN = nN_; nwg = nM * nN; G = G_; c = c_; }
    __device__ __forceinline__ bool tile(int i, int& pm, int& pn) const {
        const long L = (long)i * G + c; if (L >= nwg) return false;
        int wgid = (int)L; { const int q = nwg / 8, r = nwg % 8, xcd = wgid % 8, off = wgid / 8; wgid = (xcd < r ? xcd * (q + 1) : r * (q + 1) + (xcd - r) * q) + off; }
        const int nig = 8 * nN, gid = wgid / nig, fm = gid * 8, gsz = (nM - fm) < 8 ? (nM - fm) : 8;
        pm = fm + ((wgid % nig) % gsz); pn = (wgid % nig) / gsz; return true;
    }
};

template <class Epi, class Sched, bool GATHER, bool ALIGN_EPI, bool FP8 = false>
__device__ __forceinline__ void gemm_phase(LAS unsigned char* lds, const int lda2, const int ldb2, const int nt, const Sched& S, const Epi& E, LAS const unsigned short* tab, const int scl_e8 = 127) {
    const int sclv = scl_e8 * 0x01010101;
    int tid_ = threadIdx.x; asm volatile("" : "+v"(tid_));
    const int tid = tid_, wid = __builtin_amdgcn_readfirstlane(tid >> 6), lane = tid & 63, wr = wid >> 2, wc = wid & 3, fr = lane & 15, fq = lane >> 4;
    int Ri[2], Ci[2]; unsigned voffB[2];
#pragma unroll
    for (int i = 0; i < 2; ++i) { int R, C; stage_rc(tid * 16 + i * 8192, R, C); Ri[i] = R; Ci[i] = C; const int Rb = (R & ~31) + perm32(R & 31); voffB[i] = (unsigned)(Rb * ldb2 + C * 2); }
    const size_t kstep = (size_t)(BK * 2);
    const size_t hstepB = (size_t)HALF * ldb2;
    const unsigned ldsw = (unsigned)wid * 1024u;
    const int aoff = lds_byte(wr * 64 + fr, fq * 8), boff = lds_byte(wc * 32 + fr, fq * 8);
#define PG8_SA(b, h) (((b) * 2 + (h)) * HTB)
#define PG8_SB(b, h) ((4 + (b) * 2 + (h)) * HTB)
#define PG8_STAGE2(bufoff, gbase, o0, o1) do { \
        __builtin_amdgcn_global_load_lds((const unsigned*)((const char*)(gbase) + (o0)), (LAS unsigned*)(lds + (bufoff) + ldsw), 16, 0, 0); \
        __builtin_amdgcn_global_load_lds((const unsigned*)((const char*)(gbase) + (o1)), (LAS unsigned*)(lds + (bufoff) + ldsw + 8192), 16, 0, 0); } while (0)
#define PG8_STAGEB(bufoff, gbase) PG8_STAGE2(bufoff, gbase, voffB[0], voffB[1])
#define PG8_RD(dst, ad, off) asm volatile("ds_read_b128 %0, %1 offset:%2" : "+v"(dst) : "v"(ad), "n"(off))
#define PG8_LDA(dst, b, h) do { if constexpr (FP8) { const unsigned ad_ = lbase + (unsigned)(PG8_SA(b, h) + aoff); _Pragma("unroll") for (int m = 0; m < 4; ++m) { PG8_RD(dst##lo[m], ad_, m * 2048); PG8_RD(dst##hi[m], ad_, m * 2048 + 1024); } } \
        else { _Pragma("unroll") for (int m = 0; m < 4; ++m) _Pragma("unroll") for (int k = 0; k < 2; ++k) dst[m][k] = *(const LAS bf16x8*)(lds + PG8_SA(b, h) + aoff + m * 2048 + k * 1024); } } while (0)
#define PG8_LDB(dst, b, h) do { if constexpr (FP8) { const unsigned ad_ = lbase + (unsigned)(PG8_SB(b, h) + boff); _Pragma("unroll") for (int n = 0; n < 2; ++n) { PG8_RD(dst##lo[n], ad_, n * 2048); PG8_RD(dst##hi[n], ad_, n * 2048 + 1024); } } \
        else { _Pragma("unroll") for (int n = 0; n < 2; ++n) _Pragma("unroll") for (int k = 0; k < 2; ++k) dst[n][k] = *(const LAS bf16x8*)(lds + PG8_SB(b, h) + boff + n * 2048 + k * 1024); } } while (0)
#define PG8_CAT(x0, x1) __builtin_shufflevector(__builtin_bit_cast(v4i, x0), __builtin_bit_cast(v4i, x1), 0, 1, 2, 3, 4, 5, 6, 7)
#define PG8_MMA(ai, bj, At, Bt) do { __builtin_amdgcn_s_setprio(1); _Pragma("unroll") for (int m = 0; m < 4; ++m) _Pragma("unroll") for (int n = 0; n < 2; ++n) { \
        if constexpr (FP8) acc[ai][bj][m][n] = __builtin_amdgcn_mfma_scale_f32_16x16x128_f8f6f4(PG8_CAT(Bt##lo[n], Bt##hi[n]), PG8_CAT(At##lo[m], At##hi[m]), acc[ai][bj][m][n], 0, 0, 0, 0x7f7f7f7f, 0, sclv); \
        else { _Pragma("unroll") for (int k = 0; k < 2; ++k) acc[ai][bj][m][n] = __builtin_amdgcn_mfma_f32_16x16x32_bf16(Bt[n][k], At[m][k], acc[ai][bj][m][n], 0, 0, 0); } } \
        __builtin_amdgcn_s_setprio(0); } while (0)
#define PG8_WAIT_V(n) asm volatile("s_waitcnt vmcnt(" #n ")" ::: "memory")
#define PG8_WAIT_L(n) asm volatile("s_waitcnt lgkmcnt(" #n ")" ::: "memory")
#define PG8_BAR __builtin_amdgcn_s_barrier()
#define PG8_SCHED __builtin_amdgcn_sched_barrier(0)
#define PG8_SETA(dst, u) do { _Pragma("unroll") for (int h = 0; h < 2; ++h) _Pragma("unroll") for (int i = 0; i < 2; ++i) { \
        if (GATHER) { const unsigned tok = tab[(u).slot * 256 + h * 128 + Ri[i]]; dst[h][i] = tok * (unsigned)lda2 + (unsigned)(Ci[i] * 2); } \
        else dst[h][i] = (unsigned)((h * 128 + Ri[i]) * lda2 + Ci[i] * 2); } } while (0)
    UnitD cur, nxt; int ui = 0;
    if (!S.get(0, cur)) return;
    unsigned cv[2][2], nv[2][2];
    PG8_SETA(cv, cur);
    f32x4 acc[2][2][4][2];
#pragma unroll
    for (int a = 0; a < 2; ++a)
#pragma unroll
        for (int b = 0; b < 2; ++b)
#pragma unroll
            for (int m = 0; m < 4; ++m)
#pragma unroll
                for (int n = 0; n < 2; ++n) acc[a][b][m][n] = (f32x4){0.f, 0.f, 0.f, 0.f};
    bf16x8 At[4][2], B0[2][2], B1[2][2];
    v4i Atlo[4], Athi[4], B0lo[2], B0hi[2], B1lo[2], B1hi[2];
    if constexpr (FP8) { _Pragma("unroll") for (int m = 0; m < 4; ++m) { Atlo[m] = (v4i){0, 0, 0, 0}; Athi[m] = (v4i){0, 0, 0, 0}; } _Pragma("unroll") for (int n = 0; n < 2; ++n) { B0lo[n] = B0hi[n] = B1lo[n] = B1hi[n] = (v4i){0, 0, 0, 0}; } }
    const unsigned lbase = (unsigned)(size_t)lds;
    const char* cA = cur.A; const char* cB = cur.B;
    PG8_STAGEB(PG8_SB(0, 0), cB); PG8_STAGEB(PG8_SB(0, 1), cB + hstepB); PG8_STAGE2(PG8_SA(0, 0), cA, cv[0][0], cv[0][1]); PG8_STAGE2(PG8_SA(0, 1), cA, cv[1][0], cv[1][1]);
    if (wr == 1) PG8_BAR;
    PG8_WAIT_V(2); PG8_BAR;
    PG8_STAGEB(PG8_SB(1, 0), cB + kstep); PG8_STAGE2(PG8_SA(1, 0), cA + kstep, cv[0][0], cv[0][1]); PG8_STAGEB(PG8_SB(1, 1), cB + hstepB + kstep);
    PG8_WAIT_V(6); PG8_BAR;
    for (;;) {
        const bool has_next = S.get(ui + 1, nxt);
        const char* nA = has_next ? nxt.A : cA; const char* nB = has_next ? nxt.B : cB;
        if (GATHER) { if (has_next) PG8_SETA(nv, nxt); else { nv[0][0] = cv[0][0]; nv[0][1] = cv[0][1]; nv[1][0] = cv[1][0]; nv[1][1] = cv[1][1]; } }
        else { nv[0][0] = cv[0][0]; nv[0][1] = cv[0][1]; nv[1][0] = cv[1][0]; nv[1][1] = cv[1][1]; }
        for (int t = 0; t < nt; t += 2) {
            const bool last = (t == nt - 2);
            const char* a1 = cA + (size_t)(t + 1) * kstep;
            const char* a2 = last ? nA : cA + (size_t)(t + 2) * kstep; const char* b2 = last ? nB : cB + (size_t)(t + 2) * kstep;
            const char* a3 = a2 + kstep; const char* b3 = b2 + kstep;
            const unsigned x00 = last ? nv[0][0] : cv[0][0], x01 = last ? nv[0][1] : cv[0][1], x10 = last ? nv[1][0] : cv[1][0], x11 = last ? nv[1][1] : cv[1][1];
            PG8_LDB(B0, 0, 0); PG8_LDB(B1, 0, 1); PG8_SCHED; PG8_LDA(At, 0, 0); PG8_STAGE2(PG8_SA(1, 1), a1, cv[1][0], cv[1][1]);
            PG8_WAIT_V(8); PG8_WAIT_L(0); PG8_BAR; PG8_MMA(0, 0, At, B0); PG8_MMA(0, 1, At, B1); PG8_BAR; PG8_SCHED;
            PG8_LDA(At, 0, 1); PG8_STAGEB(PG8_SB(0, 0), b2); PG8_STAGEB(PG8_SB(0, 1), b2 + hstepB); PG8_STAGE2(PG8_SA(0, 0), a2, x00, x01);
            PG8_WAIT_V(8); PG8_WAIT_L(0); PG8_BAR; PG8_MMA(1, 0, At, B0); PG8_MMA(1, 1, At, B1); PG8_BAR; PG8_SCHED;
            PG8_LDB(B0, 1, 0); PG8_LDB(B1, 1, 1); PG8_SCHED; PG8_LDA(At, 1, 0); PG8_STAGE2(PG8_SA(0, 1), a2, x10, x11);
            PG8_WAIT_V(8); PG8_WAIT_L(0); PG8_BAR; PG8_MMA(0, 0, At, B0); PG8_MMA(0, 1, At, B1); PG8_BAR; PG8_SCHED;
            PG8_LDA(At, 1, 1); PG8_STAGEB(PG8_SB(1, 0), b3); PG8_STAGEB(PG8_SB(1, 1), b3 + hstepB); PG8_STAGE2(PG8_SA(1, 0), a3, x00, x01);
            PG8_WAIT_V(8); PG8_WAIT_L(0); PG8_BAR; PG8_MMA(1, 0, At, B0); PG8_MMA(1, 1, At, B1); PG8_BAR; PG8_SCHED;
        }
        if constexpr (ALIGN_EPI) { if (wr == 0) PG8_BAR; }
        bool zero = true;
        if constexpr (!after_drain<Epi>::value) zero = E(acc, cur, wr, wc, fr, fq);
        if (!has_next) break;
        if (zero) {
#pragma unroll
            for (int a = 0; a < 2; ++a)
#pragma unroll
                for (int b = 0; b < 2; ++b)
#pragma unroll
                    for (int m = 0; m < 4; ++m)
#pragma unroll
                        for (int n = 0; n < 2; ++n) acc[a][b][m][n] = (f32x4){0.f, 0.f, 0.f, 0.f};
        }
        cur = nxt; cA = nA; cB = nB; ++ui;
        cv[0][0] = nv[0][0]; cv[0][1] = nv[0][1]; cv[1][0] = nv[1][0]; cv[1][1] = nv[1][1];
        if constexpr (ALIGN_EPI) { if (wr == 1) PG8_BAR; }
    }
    PG8_WAIT_V(0);
    if constexpr (!ALIGN_EPI) { if (wr == 0) PG8_BAR; }
    PG8_BAR;
    if constexpr (after_drain<Epi>::value) E.fused(acc, cur, wr, wc, fr, fq, lds);
#undef PG8_SA
#undef PG8_SB
#undef PG8_STAGE2
#undef PG8_STAGEB
#undef PG8_LDA
#undef PG8_RD
#undef PG8_LDB
#undef PG8_MMA
#undef PG8_CAT
#undef PG8_WAIT_V
#undef PG8_WAIT_L
#undef PG8_BAR
#undef PG8_SCHED
#undef PG8_SETA
}
}

using pg8::UnitD;
#define EPI_LOOP_BEGIN _Pragma("unroll") for (int ai = 0; ai < 2; ++ai) _Pragma("unroll") for (int m = 0; m < 4; ++m) { const int row = u.pm * 256 + ai * 128 + wr * 64 + m * 16 + fr; _Pragma("unroll") for (int bj = 0; bj < 2; ++bj) { const int col8 = bj * 128 + wc * 32 + 8 * fq; f32x4 v0 = acc[ai][bj][m][0], v1 = acc[ai][bj][m][1];
#define EPI_LOOP_END } }
__device__ __forceinline__ v4u pack8(f32x4 v0, f32x4 v1) { v4u w; w.x = pk2(v0[0], v0[1]); w.y = pk2(v0[2], v0[3]); w.z = pk2(v1[0], v1[1]); w.w = pk2(v1[2], v1[3]); return w; }
__device__ __forceinline__ void unpack8(v4u w, f32x4& a, f32x4& b) { a = (f32x4){bflo(w.x), bfhi(w.x), bflo(w.y), bfhi(w.y)}; b = (f32x4){bflo(w.z), bfhi(w.z), bflo(w.w), bfhi(w.w)}; }

struct EpiProj {
    bf16* O;
    __device__ __forceinline__ bool operator()(f32x4 (&acc)[2][2][4][2], const UnitD& u, int wr, int wc, int fr, int fq) const {
        const int pn = u.pn;
        const float sc = ((pn < 4) ? (0.125f * LOG2E) : ((pn == 7 || pn == 8) ? 0.08838834764831845f : 1.0f));
        const bool sig = pn >= 13;
        EPI_LOOP_BEGIN
            v0 = v0 * sc; v1 = v1 * sc;
            if (sig) {
#pragma unroll
                for (int j = 0; j < 4; ++j) { v0[j] = sigmoidf_(v0[j]); v1[j] = sigmoidf_(v1[j]); }
            }
            { const int g0 = pn * 256 + bj * 128; int C, W;
              if (g0 < C_K) { C = C_Q; W = 1024; } else if (g0 < C_V) { C = C_K; W = 128; } else if (g0 < C_MQ) { C = C_V; W = 128; } else if (g0 < C_MK) { C = C_MQ; W = 512; } else if (g0 < C_MV) { C = C_MK; W = 512; }
              else if (g0 < C_MO) { C = C_MV; W = 1024; } else if (g0 < C_GA) { C = C_MO; W = 1024; } else if (g0 < C_GB) { C = C_GA; W = 2048; } else { C = C_GB; W = 2048; }
              *(v4u*)(PSEG(O, C) + (size_t)row * W + (pn * 256 + col8 - C)) = pack8(v0, v1); }
        EPI_LOOP_END
        return true;
    }
};
struct EpiMerge {
    const bf16* P; bf16* O;
    __device__ __forceinline__ bool operator()(f32x4 (&acc)[2][2][4][2], const UnitD& u, int wr, int wc, int fr, int fq) const {
        if (u.aux == 0) {
#pragma unroll
            for (int ai = 0; ai < 2; ++ai) {
                v4u gav[4][2], gbw[4][2];
#pragma unroll
                for (int m = 0; m < 4; ++m)
#pragma unroll
                    for (int bj = 0; bj < 2; ++bj) { const size_t o = (size_t)(u.pm * 256 + ai * 128 + wr * 64 + m * 16 + fr) * 2048 + u.pn * 256 + bj * 128 + wc * 32 + 8 * fq; gav[m][bj] = __builtin_nontemporal_load((const v4u*)(PSEG(P, C_GA) + o)); gbw[m][bj] = *(const v4u*)(PSEG(P, C_GB) + o); }
#pragma unroll
                for (int m = 0; m < 4; ++m)
#pragma unroll
                    for (int bj = 0; bj < 2; ++bj) {
                        f32x4 v0 = acc[ai][bj][m][0], v1 = acc[ai][bj][m][1];
                        f32x4 a0, a1, b0, b1; unpack8(gav[m][bj], a0, a1); unpack8(gbw[m][bj], b0, b1);
#pragma unroll
                        for (int j = 0; j < 4; ++j) { v0[j] = v0[j] * a0[j] * fast_rcp(b0[j]); v1[j] = v1[j] * a1[j] * fast_rcp(b1[j]); }
                        acc[ai][bj][m][0] = v0; acc[ai][bj][m][1] = v1;
                    }
            }
            return false;
        } else {
            v4u gbv2[2][4][2];
#pragma unroll
            for (int ai = 0; ai < 2; ++ai)
#pragma unroll
                for (int m = 0; m < 4; ++m)
#pragma unroll
                    for (int bj = 0; bj < 2; ++bj) gbv2[ai][m][bj] = __builtin_nontemporal_load((const v4u*)(PSEG(P, C_GB) + (size_t)(u.pm * 256 + ai * 128 + wr * 64 + m * 16 + fr) * 2048 + u.pn * 256 + bj * 128 + wc * 32 + 8 * fq));
#pragma unroll
            for (int ai = 0; ai < 2; ++ai) {
                const v4u (&gbv)[4][2] = gbv2[ai];
#pragma unroll
                for (int m = 0; m < 4; ++m)
#pragma unroll
                    for (int bj = 0; bj < 2; ++bj) {
                        const int row = u.pm * 256 + ai * 128 + wr * 64 + m * 16 + fr, col8 = bj * 128 + wc * 32 + 8 * fq;
                        f32x4 v0 = acc[ai][bj][m][0], v1 = acc[ai][bj][m][1];
                        f32x4 b0, b1; unpack8(gbv[m][bj], b0, b1);
                        v0 = v0 * b0; v1 = v1 * b1;
                        if (FP8_P6) { v2u o8; o8.x = pk4_fp8(v0[0] * MG8_SCALE, v0[1] * MG8_SCALE, v0[2] * MG8_SCALE, v0[3] * MG8_SCALE); o8.y = pk4_fp8(v1[0] * MG8_SCALE, v1[1] * MG8_SCALE, v1[2] * MG8_SCALE, v1[3] * MG8_SCALE);
                            *(v2u*)((unsigned char*)O + (size_t)row * D + u.pn * 256 + col8) = o8; }
                        else *(v4u*)(O + (size_t)row * D + u.pn * 256 + col8) = pack8(v0, v1);
                    }
            }
            return true;
        }
    }
};
struct EpiResid {
    bf16* H; float scale;
    __device__ __forceinline__ bool operator()(f32x4 (&acc)[2][2][4][2], const UnitD& u, int wr, int wc, int fr, int fq) const {
        EPI_LOOP_BEGIN
            bf16* p = H + (size_t)row * D + u.pn * 256 + col8;
            const v4u hv = *(const v4u*)p; f32x4 h0, h1; unpack8(hv, h0, h1);
            v0 = v0 * scale + h0 * ALPHA; v1 = v1 * scale + h1 * ALPHA;
            *(v4u*)p = pack8(v0, v1);
        EPI_LOOP_END
        return true;
    }
};
struct EpiGU {
    unsigned char* HB; const float* roww;
    __device__ __forceinline__ bool operator()(f32x4 (&acc)[2][2][4][2], const UnitD& u, int wr, int wc, int fr, int fq) const {
#pragma unroll
        for (int ai = 0; ai < 2; ++ai) {
            float wv[4];
#pragma unroll
            for (int m = 0; m < 4; ++m) wv[m] = roww[u.pm * 256 + ai * 128 + wr * 64 + m * 16 + fr];
#pragma unroll
            for (int m = 0; m < 4; ++m) {
                const int row = u.pm * 256 + ai * 128 + wr * 64 + m * 16 + fr;
                const float w = wv[m];
                const f32x4 g0 = acc[ai][0][m][0], u0 = acc[ai][1][m][0], g1 = acc[ai][0][m][1], u1 = acc[ai][1][m][1];
                f32x4 r0, r1; const float ws_ = w * HB8_SCALE;
#pragma unroll
                for (int j = 0; j < 4; ++j) { r0[j] = g0[j] * sigmoidf_(g0[j]) * u0[j] * ws_; r1[j] = g1[j] * sigmoidf_(g1[j]) * u1[j] * ws_; }
                v2u o; o.x = pk4_fp8(r0[0], r0[1], r0[2], r0[3]); o.y = pk4_fp8(r1[0], r1[1], r1[2], r1[3]);
                *(v2u*)(HB + (size_t)row * DE + u.pn * 128 + wc * 32 + 8 * fq) = o;
            }
        }
        return true;
    }
};
struct EpiStore {
    bf16* O; int ldo; float scale;
    __device__ __forceinline__ bool operator()(f32x4 (&acc)[2][2][4][2], const UnitD& u, int wr, int wc, int fr, int fq) const {
        EPI_LOOP_BEGIN
            v0 = v0 * scale; v1 = v1 * scale;
            *(v4u*)(O + (size_t)row * ldo + u.aux + col8) = pack8(v0, v1);
        EPI_LOOP_END
        return true;
    }
};
__device__ __forceinline__ void store_fp8_wide(unsigned char* base  , size_t ldo, const v2u (&o)[4], int fq) {
    const bool odd = fq & 1;
#pragma unroll
    for (int p = 0; p < 2; ++p) {
        const v2u mine = odd ? o[2 * p + 1] : o[2 * p], send = odd ? o[2 * p] : o[2 * p + 1];
        v2u recv; recv.x = __shfl_xor(send.x, 16); recv.y = __shfl_xor(send.y, 16);
        v4u w; if (odd) { w.x = recv.x; w.y = recv.y; w.z = mine.x; w.w = mine.y; } else { w.x = mine.x; w.y = mine.y; w.z = recv.x; w.w = recv.y; }
        *(v4u*)(base + (size_t)((2 * p + (odd ? 1 : 0)) * 16) * ldo + 8 * (fq & ~1)) = w;
    }
}
__device__ __forceinline__ unsigned pk4_fp8_nc(float a, float b, float c, float d) { unsigned r = (unsigned)__builtin_amdgcn_cvt_pk_fp8_f32(a, b, 0, false); return (unsigned)__builtin_amdgcn_cvt_pk_fp8_f32(c, d, (int)r, true); }
struct EpiStore8 {
    unsigned char* O; int ldo;
    __device__ __forceinline__ bool operator()(f32x4 (&acc)[2][2][4][2], const UnitD& u, int wr, int wc, int fr, int fq) const {
#pragma unroll
        for (int ai = 0; ai < 2; ++ai)
#pragma unroll
            for (int bj = 0; bj < 2; ++bj) {
                v2u o[4];
#pragma unroll
                for (int m = 0; m < 4; ++m) { const f32x4 v0 = acc[ai][bj][m][0], v1 = acc[ai][bj][m][1]; o[m].x = pk4_fp8_nc(v0[0], v0[1], v0[2], v0[3]); o[m].y = pk4_fp8_nc(v1[0], v1[1], v1[2], v1[3]); }
                store_fp8_wide(O + (size_t)(u.pm * 256 + ai * 128 + wr * 64 + fr) * ldo + u.aux + bj * 128 + wc * 32, (size_t)ldo, o, fq);
            }
        return true;
    }
};
struct EpiPle {
    const bf16* X2; const bf16* PP; bf16* O; float scale;
    __device__ __forceinline__ bool operator()(f32x4 (&acc)[2][2][4][2], const UnitD& u, int wr, int wc, int fr, int fq) const {
        EPI_LOOP_BEGIN
            const size_t o = (size_t)row * D + u.pn * 256 + col8;
            const v4u xv = *(const v4u*)(X2 + o), pv = *(const v4u*)(PP + o);
            f32x4 x0, x1, p0, p1; unpack8(xv, x0, x1); unpack8(pv, p0, p1);
#pragma unroll
            for (int j = 0; j < 4; ++j) { v0[j] = x0[j] * ALPHA + p0[j] * sigmoidf_(v0[j] * scale); v1[j] = x1[j] * ALPHA + p1[j] * sigmoidf_(v1[j] * scale); }
            *(v4u*)(O + o) = pack8(v0, v1);
        EPI_LOOP_END
        return true;
    }
};

struct EpiPleLn {
    static constexpr bool AFTER_DRAIN = true;
    const bf16* X2; const bf16* PP; float* out; const float* ln_g; const float* ln_b; unsigned long long* xslot; unsigned* cnt;
    __device__ __forceinline__ void fused(f32x4 (&acc)[2][2][4][2], const UnitD& u, int wr, int wc, int fr, int fq, LAS unsigned char* lds) const {
        LAS f32x2* P = (LAS f32x2*)lds;
        LAS f32x2* S = (LAS f32x2*)(lds + 8192);
#pragma unroll
        for (int ai = 0; ai < 2; ++ai)
            {
                v4u xv[4][2], pv[4][2];
#pragma unroll
                for (int ml = 0; ml < 4; ++ml)
#pragma unroll
                    for (int bj = 0; bj < 2; ++bj) { const size_t o = (size_t)(u.pm * 256 + ai * 128 + wr * 64 + ml * 16 + fr) * D + u.pn * 256 + bj * 128 + wc * 32 + 8 * fq; xv[ml][bj] = __builtin_nontemporal_load((const v4u*)(X2 + o)); pv[ml][bj] = __builtin_nontemporal_load((const v4u*)(PP + o)); }
#pragma unroll
                for (int ml = 0; ml < 4; ++ml)
#pragma unroll
                    for (int bj = 0; bj < 2; ++bj) { const int m = ml;
                        f32x4 v0 = acc[ai][bj][m][0], v1 = acc[ai][bj][m][1];
                        f32x4 x0, x1, p0, p1; unpack8(xv[ml][bj], x0, x1); unpack8(pv[ml][bj], p0, p1);
#pragma unroll
                        for (int j = 0; j < 4; ++j) { v0[j] = x0[j] * ALPHA + p0[j] * sigmoidf_(v0[j]); v1[j] = x1[j] * ALPHA + p1[j] * sigmoidf_(v1[j]); }
                        acc[ai][bj][m][0] = v0; acc[ai][bj][m][1] = v1;
                        asm volatile("" : "+v"(acc[ai][bj][m][0]), "+v"(acc[ai][bj][m][1]) :: "memory");
                    }
            }
#pragma unroll
        for (int ai = 0; ai < 2; ++ai)
#pragma unroll
            for (int m = 0; m < 4; ++m) {
                float sm = 0.f, sq = 0.f;
#pragma unroll
                for (int bj = 0; bj < 2; ++bj)
#pragma unroll
                    for (int n = 0; n < 2; ++n) { const f32x4 x = acc[ai][bj][m][n]; sm += (x[0] + x[1]) + (x[2] + x[3]); sq += (x[0] * x[0] + x[1] * x[1]) + (x[2] * x[2] + x[3] * x[3]); }
                sm += __shfl_xor(sm, 16); sm += __shfl_xor(sm, 32); sq += __shfl_xor(sq, 16); sq += __shfl_xor(sq, 32);
                if (fq == 0) P[(ai * 128 + wr * 64 + m * 16 + fr) * 4 + wc] = (f32x2){sm, sq};
            }
        LBAR();
        const int t = threadIdx.x;
        if (t < 256) { const f32x2 a = P[t * 4 + 0], b = P[t * 4 + 1], c = P[t * 4 + 2], d = P[t * 4 + 3];
            const float ts = (a[0] + b[0]) + (c[0] + d[0]), tq = (a[1] + b[1]) + (c[1] + d[1]);
            const unsigned long long pk = ((unsigned long long)__float_as_uint(tq) << 32) | (unsigned long long)__float_as_uint(ts);
            __hip_atomic_store(xslot + ((size_t)u.pm * 256 + t) * 8 + u.pn, pk, __ATOMIC_RELAXED, __HIP_MEMORY_SCOPE_AGENT); }
        asm volatile("s_waitcnt vmcnt(0)" ::: "memory");
        __syncthreads();
        unsigned* pc = cnt + (size_t)u.pm * 64;
        if (t == 0) {
            (void)__hip_atomic_fetch_add(pc, 1u, __ATOMIC_RELAXED, __HIP_MEMORY_SCOPE_AGENT);
            unsigned polls = 0;
            while (__hip_atomic_load(pc, __ATOMIC_RELAXED, __HIP_MEMORY_SCOPE_AGENT) < 8u) { __builtin_amdgcn_s_sleep(2); if (++polls > (1u << 22)) break; }
            __builtin_amdgcn_fence(__ATOMIC_ACQUIRE, "agent");
            asm volatile("s_waitcnt vmcnt(0)" ::: "memory");
        }
        __syncthreads();
        if (t < 256) { float ts = 0.f, tq = 0.f;
#pragma unroll
            for (int k = 0; k < 8; ++k) { const unsigned long long pk = __hip_atomic_load(xslot + ((size_t)u.pm * 256 + t) * 8 + k, __ATOMIC_RELAXED, __HIP_MEMORY_SCOPE_AGENT); ts += __uint_as_float((unsigned)pk); tq += __uint_as_float((unsigned)(pk >> 32)); }
            const float mean = ts * (1.f / D), var = fmaxf(tq * (1.f / D) - mean * mean, 0.f);
            S[t] = (f32x2){mean, rsqrtf(var + LN_EPS)}; }
        LBAR();
#pragma unroll
        for (int bj = 0; bj < 2; ++bj) {
            const int col = u.pn * 256 + bj * 128 + wc * 32 + 8 * fq;
            const f32x4 g0 = *(const f32x4*)(ln_g + col), g1 = *(const f32x4*)(ln_g + col + 4), b0 = *(const f32x4*)(ln_b + col), b1 = *(const f32x4*)(ln_b + col + 4);
#pragma unroll
            for (int ai = 0; ai < 2; ++ai)
#pragma unroll
                for (int m = 0; m < 4; ++m) {
                    const int rl = ai * 128 + wr * 64 + m * 16 + fr; const f32x2 st = S[rl];
                    const f32x4 v0 = acc[ai][bj][m][0], v1 = acc[ai][bj][m][1]; f32x4 y0, y1;
#pragma unroll
                    for (int j = 0; j < 4; ++j) { y0[j] = (v0[j] - st[0]) * st[1] * g0[j] + b0[j]; y1[j] = (v1[j] - st[0]) * st[1] * g1[j] + b1[j]; }
                    float* o = out + (size_t)(u.pm * 256 + rl) * D + col; *(f32x4*)o = y0; *(f32x4*)(o + 4) = y1;
                    asm volatile("" ::: "memory"); __builtin_amdgcn_sched_barrier(0);
                }
        }
        LBAR();
    }
};
struct EpiResidLn {
    static constexpr bool AFTER_DRAIN = true;
    bf16* H; unsigned char* X8; const float* ln_g; const float* ln_b; unsigned long long* xslot; unsigned* cnt;
    __device__ __forceinline__ void fused(f32x4 (&acc)[2][2][4][2], const UnitD& u, int wr, int wc, int fr, int fq, LAS unsigned char* lds) const {
        LAS f32x2* P = (LAS f32x2*)lds;
        LAS f32x2* S = (LAS f32x2*)(lds + 8192);
        v4u hv2[2][4][2];
#pragma unroll
        for (int ai = 0; ai < 2; ++ai)
#pragma unroll
            for (int m = 0; m < 4; ++m)
#pragma unroll
                for (int bj = 0; bj < 2; ++bj) hv2[ai][m][bj] = __builtin_nontemporal_load((const v4u*)(H + (size_t)(u.pm * 256 + ai * 128 + wr * 64 + m * 16 + fr) * D + u.pn * 256 + bj * 128 + wc * 32 + 8 * fq));
#pragma unroll
        for (int ai = 0; ai < 2; ++ai) {
            const v4u (&hv)[4][2] = hv2[ai];
#pragma unroll
            for (int m = 0; m < 4; ++m)
#pragma unroll
                for (int bj = 0; bj < 2; ++bj) {
                    f32x4 v0 = acc[ai][bj][m][0], v1 = acc[ai][bj][m][1];
                    f32x4 h0, h1; unpack8(hv[m][bj], h0, h1);
                    v0 = v0 + h0 * ALPHA; v1 = v1 + h1 * ALPHA;
                    acc[ai][bj][m][0] = v0; acc[ai][bj][m][1] = v1;
                    asm volatile("" : "+v"(acc[ai][bj][m][0]), "+v"(acc[ai][bj][m][1]) :: "memory");
                }
        }
#pragma unroll
        for (int ai = 0; ai < 2; ++ai)
#pragma unroll
            for (int m = 0; m < 4; ++m) {
                float sm = 0.f, sq = 0.f;
#pragma unroll
                for (int bj = 0; bj < 2; ++bj)
#pragma unroll
                    for (int n = 0; n < 2; ++n) { const f32x4 x = acc[ai][bj][m][n]; sm += (x[0] + x[1]) + (x[2] + x[3]); sq += (x[0] * x[0] + x[1] * x[1]) + (x[2] * x[2] + x[3] * x[3]); }
                sm += __shfl_xor(sm, 16); sm += __shfl_xor(sm, 32); sq += __shfl_xor(sq, 16); sq += __shfl_xor(sq, 32);
                if (fq == 0) P[(ai * 128 + wr * 64 + m * 16 + fr) * 4 + wc] = (f32x2){sm, sq};
            }
        LBAR();
        const int t = threadIdx.x;
        if (t < 256) { const f32x2 a = P[t * 4 + 0], b = P[t * 4 + 1], c = P[t * 4 + 2], d = P[t * 4 + 3];
            const float ts = (a[0] + b[0]) + (c[0] + d[0]), tq = (a[1] + b[1]) + (c[1] + d[1]);
            const unsigned long long pk = ((unsigned long long)__float_as_uint(tq) << 32) | (unsigned long long)__float_as_uint(ts);
            __hip_atomic_store(xslot + ((size_t)u.pm * 256 + t) * 8 + u.pn, pk, __ATOMIC_RELAXED, __HIP_MEMORY_SCOPE_AGENT); }
        asm volatile("s_waitcnt vmcnt(0)" ::: "memory");
        __syncthreads();
        unsigned* pc = cnt + (size_t)u.pm * 64;
        if (t == 0) {
            (void)__hip_atomic_fetch_add(pc, 1u, __ATOMIC_RELAXED, __HIP_MEMORY_SCOPE_AGENT);
            unsigned polls = 0;
            while (__hip_atomic_load(pc, __ATOMIC_RELAXED, __HIP_MEMORY_SCOPE_AGENT) < 8u) { __builtin_amdgcn_s_sleep(2); if (++polls > (1u << 22)) break; }
            __builtin_amdgcn_fence(__ATOMIC_ACQUIRE, "agent");
            asm volatile("s_waitcnt vmcnt(0)" ::: "memory");
        }
        __syncthreads();
        if (t < 256) { float ts = 0.f, tq = 0.f;
#pragma unroll
            for (int k = 0; k < 8; ++k) { const unsigned long long pk = __hip_atomic_load(xslot + ((size_t)u.pm * 256 + t) * 8 + k, __ATOMIC_RELAXED, __HIP_MEMORY_SCOPE_AGENT); ts += __uint_as_float((unsigned)pk); tq += __uint_as_float((unsigned)(pk >> 32)); }
            const float mean = ts * (1.f / D), var = fmaxf(tq * (1.f / D) - mean * mean, 0.f);
            S[t] = (f32x2){mean, rsqrtf(var + LN_EPS)}; }
        LBAR();
#pragma unroll
        for (int bj = 0; bj < 2; ++bj) {
            const int col = u.pn * 256 + bj * 128 + wc * 32 + 8 * fq;
            const f32x4 g0 = *(const f32x4*)(ln_g + col), g1 = *(const f32x4*)(ln_g + col + 4), b0 = *(const f32x4*)(ln_b + col), b1 = *(const f32x4*)(ln_b + col + 4);
#pragma unroll
            for (int ai = 0; ai < 2; ++ai)
#pragma unroll
                for (int m = 0; m < 4; ++m) {
                    const int rl = ai * 128 + wr * 64 + m * 16 + fr; const f32x2 st = S[rl];
                    const f32x4 v0 = acc[ai][bj][m][0], v1 = acc[ai][bj][m][1]; f32x4 y0, y1;
#pragma unroll
                    for (int j = 0; j < 4; ++j) { y0[j] = (v0[j] - st[0]) * st[1] * g0[j] + b0[j]; y1[j] = (v1[j] - st[0]) * st[1] * g1[j] + b1[j]; }
                    const size_t o = (size_t)(u.pm * 256 + rl) * D + col; *(v4u*)(H + o) = pack8(y0, y1);
                    v2u o8; o8.x = pk4_fp8(y0[0], y0[1], y0[2], y0[3]); o8.y = pk4_fp8(y1[0], y1[1], y1[2], y1[3]); *(v2u*)(X8 + o) = o8;
                    asm volatile("" ::: "memory"); __builtin_amdgcn_sched_barrier(0);
                }
        }
        LBAR();
    }
};
struct SchedPanel {
    int G, vcu, k, nM; const char* A; const char* B; size_t ta, tb;
    __device__ __forceinline__ bool get(int i, UnitD& u) const { if (i > 0) return false; const int L = k * G + vcu, pm = L >> 3, pn = L & 7; if (pm >= nM) return false;
        u.pm = pm; u.pn = pn; u.aux = pn * 256; u.slot = 0; u.A = A + (size_t)pm * ta; u.B = B + (size_t)pn * tb; return true; }
};

struct SchedDense {
    pg8::DenseOrder o; const char* A; const char* B; size_t ta, tb;
    __device__ __forceinline__ bool get(int i, UnitD& u) const { int pm, pn; if (!o.tile(i, pm, pn)) return false; u.pm = pm; u.pn = pn; u.aux = pn * 256; u.slot = 0; u.A = A + (size_t)pm * ta; u.B = B + (size_t)pn * tb; return true; }
};
struct SchedMerge {
    pg8::DenseOrder o; const char* A0; const char* A1; const char* B0; const char* B1; size_t ta, tb; int base, cnt;
    __device__ __forceinline__ bool get(int i0, UnitD& u) const { if (i0 >= cnt) return false; const int i = i0 + base; int pm, pn; if (!o.tile(i >> 1, pm, pn)) return false; const int part = i & 1; u.pm = pm; u.pn = pn; u.aux = part; u.slot = 0;
        u.A = (part ? A1 : A0) + (size_t)pm * ta; u.B = (part ? B1 : B0) + (size_t)pn * tb; return true; }
};
struct SchedGU {
    int G, vcu, ntiles; const char* X; const char* W; LAS const int* etab;
    __device__ __forceinline__ bool get(int i, UnitD& u) const { const int L = i * G + vcu, j = L >> 2; if (j >= ntiles || i >= 20) return false; const int e = etab[i];
        u.pm = j; u.pn = L & 3; u.aux = 0; u.slot = i; u.A = X; u.B = W + ((size_t)e * 1024 + (size_t)(L & 3) * 256) * (size_t)D; return true; }
};
struct SchedDown {
    int G, vcu, ntiles, chunk; const char* HB; const char* W; LAS const int* etab; bool rev;
    __device__ __forceinline__ bool get(int i, UnitD& u) const { const int L = i * G + vcu, j0 = L >> 2; if (j0 >= ntiles || i >= 64) return false; const int j = rev ? ntiles - 1 - j0 : j0; const int e = etab[i], cc = L & 3;
        u.pm = j; u.pn = cc; u.aux = cc * 256; u.slot = 0; u.A = HB + (size_t)j * 256 * DE; u.B = W + ((size_t)e * 2048 + (size_t)(chunk * 4 + cc) * 256) * (size_t)DE; return true; }
};

#define XB_TMO      128
#define XB_XCNT(j)  (256  + 64 * (j))
#define XB_XSUB(j)  (1280 + 64 * (j))
#define XB_XGEN(j)  (2304 + 64 * (j))
#define XB_TOP      3328
#define XB_TOPGEN   3392
#define XCD_BAR_WORDS 3456
#define XB_SPIN_CAP (1u << 20)

__device__ __forceinline__ unsigned xb_ld(unsigned* p)              { return __hip_atomic_load(p, __ATOMIC_RELAXED, __HIP_MEMORY_SCOPE_AGENT); }
__device__ __forceinline__ unsigned xb_add(unsigned* p, unsigned v) { return __hip_atomic_fetch_add(p, v, __ATOMIC_RELAXED, __HIP_MEMORY_SCOPE_AGENT); }
__device__ __forceinline__ unsigned xb_xcc_id() { return (unsigned)__builtin_amdgcn_s_getreg((3 << 11) | 20) & 0xFu; }
#define XB_SPIN(cond, bar) do { unsigned _sp = 0; while (cond) { __builtin_amdgcn_s_sleep(1); \
    if ((++_sp & 255u) == 0u) { if (xb_ld(&(bar)[XB_TMO])) break; if (_sp > XB_SPIN_CAP) { atomicAdd(&(bar)[XB_TMO], 1u); break; } } } } while (0)

struct XcdBarrier { unsigned* bar; unsigned x; volatile LAS unsigned* st; };

__device__ __forceinline__ XcdBarrier xcd_barrier_post(unsigned* bar, volatile LAS unsigned* st) {
    XcdBarrier b; b.bar = bar; b.x = xb_xcc_id(); b.st = st;
    if (threadIdx.x == 0) (void)xb_add(&bar[XB_XCNT(b.x)], 1u);
    return b;
}
__device__ __forceinline__ void xcd_barrier_complete(unsigned* bar, unsigned x, unsigned& nloc, unsigned& nx) {
    const unsigned G = gridDim.x * gridDim.y * gridDim.z;
    unsigned sum, cnt, mine, sp = 0u;
    for (;;) {
        sum = 0u; cnt = 0u; mine = 0u;
#pragma unroll
        for (unsigned j = 0; j < 16; ++j) { const unsigned c = xb_ld(&bar[XB_XCNT(j)]); sum += c; cnt += (c > 0u) ? 1u : 0u; mine = (j == x) ? c : mine; }
        if (sum == G) break;
        __builtin_amdgcn_s_sleep(1);
        if ((++sp & 255u) == 0u) { if (xb_ld(&bar[XB_TMO])) break; if (sp > XB_SPIN_CAP) { atomicAdd(&bar[XB_TMO], 1u); break; } }
    }
    nloc = mine > 0u ? mine : 1u; nx = cnt > 0u ? cnt : 1u;
}
__device__ __forceinline__ void xcd_barrier(const XcdBarrier& b) {
    asm volatile("s_waitcnt vmcnt(0)" ::: "memory");
    __syncthreads();
    if (threadIdx.x == 0) {
        unsigned* bar = b.bar;
        __builtin_amdgcn_s_waitcnt(0);
        unsigned nloc = b.st[0], nx = b.st[1];
        if (nloc == 0u) { xcd_barrier_complete(bar, b.x, nloc, nx); b.st[0] = nloc; b.st[1] = nx; }
        const unsigned old = xb_add(&bar[XB_XSUB(b.x)], 1u);
        const unsigned gen = old / nloc;
        if (old + 1u == (gen + 1u) * nloc) {
            __builtin_amdgcn_fence(__ATOMIC_RELEASE, "agent");
            asm volatile("s_waitcnt vmcnt(0)" ::: "memory");
            const unsigned og = xb_add(&bar[XB_TOP], 1u);
            const unsigned tg = og / nx;
            if (og + 1u == (tg + 1u) * nx) xb_add(&bar[XB_TOPGEN], 1u);
            else XB_SPIN(xb_ld(&bar[XB_TOPGEN]) == tg, bar);
            __builtin_amdgcn_fence(__ATOMIC_ACQUIRE, "agent");
            xb_add(&bar[XB_XGEN(b.x)], 1u);
            asm volatile("s_waitcnt vmcnt(0)" ::: "memory");
        } else {
            XB_SPIN(xb_ld(&bar[XB_XGEN(b.x)]) == gen, bar);
            __builtin_amdgcn_fence(__ATOMIC_ACQUIRE, "agent");
            asm volatile("s_waitcnt vmcnt(0)" ::: "memory");
        }
    }
    __syncthreads();
}

constexpr int NWAVES = 8;
struct Frame {
    LAS unsigned char* lds;
    int tid, lane, wave, vcu, G;
    unsigned char* ws;
};

__device__ __forceinline__ void tr_item(const float* W, int ldw, int srccol0, bf16* WT, size_t dstrow0, int ldk, int k0, LAS float* scr, int lane) {
#pragma unroll 8
    for (int i = 0; i < 32; ++i) { const int kk = 2 * i + (lane >> 5); scr[kk * 33 + (lane & 31)] = __builtin_nontemporal_load(W + (size_t)(k0 + kk) * ldw + srccol0 + (lane & 31)); }
    LDS_WAIT(); asm volatile("" ::: "memory");
    const int c = lane & 7;
#pragma unroll
    for (int j = 0; j < 4; ++j) { const int n = (lane >> 3) + 8 * j; const LAS float* s = scr + (8 * c) * 33 + n;
        v4u o; o.x = pk2(s[0 * 33], s[1 * 33]); o.y = pk2(s[2 * 33], s[3 * 33]); o.z = pk2(s[4 * 33], s[5 * 33]); o.w = pk2(s[6 * 33], s[7 * 33]);
        *(v4u*)(WT + (dstrow0 + n) * (size_t)ldk + k0 + 8 * c) = o; }
    LDS_WAIT(); asm volatile("" ::: "memory");
}
__device__ __forceinline__ void tr_item8(const float* W, int ldw, int srccol0, unsigned char* WT, size_t dstrow0, int ldk, int k0, LAS float* scr, int lane) {
    float ld_[32];
#pragma unroll
    for (int i = 0; i < 32; ++i) { const int kk = 2 * i + (lane >> 5); ld_[i] = __builtin_nontemporal_load(W + (size_t)(k0 + kk) * ldw + srccol0 + (lane & 31)); }
#pragma unroll
    for (int i = 0; i < 32; ++i) { const int kk = 2 * i + (lane >> 5); scr[kk * 33 + (lane & 31)] = ld_[i]; }
    LDS_WAIT(); asm volatile("" ::: "memory");
    const int c = lane & 7;
#pragma unroll
    for (int j = 0; j < 4; ++j) { const int n = (lane >> 3) + 8 * j; const LAS float* s = scr + (8 * c) * 33 + n;
        v2u o; o.x = pk4_fp8(s[0 * 33] * W8_SCALE, s[1 * 33] * W8_SCALE, s[2 * 33] * W8_SCALE, s[3 * 33] * W8_SCALE); o.y = pk4_fp8(s[4 * 33] * W8_SCALE, s[5 * 33] * W8_SCALE, s[6 * 33] * W8_SCALE, s[7 * 33] * W8_SCALE);
        *(v2u*)(WT + (dstrow0 + n) * (size_t)ldk + k0 + 8 * c) = o; }
    LDS_WAIT(); asm volatile("" ::: "memory");
}
__device__ __forceinline__ void tr_matrix_item(const float* W, int K, int N, int ldw, int srcshift_from, int srcshift, bf16* WT, int item, LAS float* scr, int lane) {
    const int nblk = N / 32, kb = item / nblk, nb = item % nblk; const int n0 = nb * 32;
    const int sc0 = n0 + (n0 >= srcshift_from ? srcshift : 0);
    tr_item(W, ldw, sc0, WT, (size_t)n0, K, kb * 64, scr, lane);
}

__device__ __forceinline__ void tr_matrix_item8(const float* W, int K, int N, int ldw, int srcshift_from, int srcshift, unsigned char* WT, int item, LAS float* scr, int lane) {
    const int nblk = N / 32, kb = item / nblk, nb = item % nblk; const int n0 = nb * 32;
    const int sc0 = n0 + (n0 >= srcshift_from ? srcshift : 0);
    tr_item8(W, ldw, sc0, WT, (size_t)n0, K, kb * 64, scr, lane);
}
__device__ __forceinline__ void ln_stats32(const float (&v)[32], float& mean, float& rstd) {
    float s = 0.f;
#pragma unroll
    for (int i = 0; i < 32; ++i) s += v[i];
    mean = wave_sum(s) * (1.f / D);
    float q = 0.f;
#pragma unroll
    for (int i = 0; i < 32; ++i) { const float d = v[i] - mean; q += d * d; }
    rstd = rsqrtf(wave_sum(q) * (1.f / D) + LN_EPS);
}

__device__ __forceinline__ void p0_prologue(Frame& F, const float* x, const float* p, const float* ln_g, const float* ln_b, const float* w_in, const float* w_ba, const float* w_bm,
                                            const float* w_out, const float* w_router, const float* w_pp, const float* w_pg) {
    unsigned char* ws = F.ws;
    LAS float* scr = (LAS float*)(F.lds + RING_OFF + F.wave * 16384);
    const int gw = F.vcu * NWAVES + F.wave, NGW = F.G * NWAVES, lane = F.lane;
    constexpr int I_WIN = 32 * (NPROJ / 32), I_WB = 16 * 64, I_WOUT = 32 * 64, I_WR = 32 * 2, I_WPP = 4 * 64, I_WPG = 32 * 64;
    constexpr int NITEMS = I_WIN + 2 * I_WB + I_WOUT + I_WR + I_WPP + I_WPG;
    for (int it = gw; it < NITEMS; it += NGW) {
        int r = it;
        if (r < I_WIN) { if (FP8_P1) tr_matrix_item8(w_in, 2048, NPROJ, WIN_LD, 4352, 8, ws + WS_WIN, r, scr, lane); else tr_matrix_item(w_in, 2048, NPROJ, WIN_LD, 4352, 8, (bf16*)(ws + WS_WIN), r, scr, lane); continue; } r -= I_WIN;
        if (r < I_WB) { tr_matrix_item(w_ba, 1024, 2048, 2048, 1 << 30, 0, (bf16*)(ws + WS_WBA), r, scr, lane); continue; } r -= I_WB;
        if (r < I_WB) { tr_matrix_item(w_bm, 1024, 2048, 2048, 1 << 30, 0, (bf16*)(ws + WS_WBM), r, scr, lane); continue; } r -= I_WB;
        if (r < I_WOUT) { if (FP8_P6) tr_matrix_item8(w_out, 2048, 2048, 2048, 1 << 30, 0, ws + WS_WOUT, r, scr, lane); else tr_matrix_item(w_out, 2048, 2048, 2048, 1 << 30, 0, (bf16*)(ws + WS_WOUT), r, scr, lane); continue; } r -= I_WOUT;
        if (r < I_WR) { tr_matrix_item(w_router, 2048, 64, 64, 1 << 30, 0, (bf16*)(ws + WS_WR), r, scr, lane); continue; } r -= I_WR;
        if (r < I_WPP) { tr_matrix_item(w_pp, 256, 2048, 2048, 1 << 30, 0, (bf16*)(ws + WS_WPP), r, scr, lane); continue; } r -= I_WPP;
        if (FP8_P14) tr_matrix_item8(w_pg, 2048, 2048, 2048, 1 << 30, 0, ws + WS_WPG, r, scr, lane); else tr_matrix_item(w_pg, 2048, 2048, 2048, 1 << 30, 0, (bf16*)(ws + WS_WPG), r, scr, lane);
    }
    { bf16* PB = (bf16*)(ws + WS_PB);
      for (size_t i = ((size_t)blockIdx.x * 512 + F.tid) * 8; i < (size_t)T * 256; i += (size_t)F.G * 512 * 8) {
          const f32x4 a = *(const f32x4*)(p + i), b = *(const f32x4*)(p + i + 4); *(v4u*)(PB + i) = pack8(a, b); } }
    __syncthreads();
    LAS float* wif = (LAS float*)(F.lds + RING_OFF);
    for (int idx = F.tid; idx < 8 * 2048; idx += 512) { const int g = idx & 7, k = idx >> 3; wif[g * 2048 + k] = w_in[(size_t)k * WIN_LD + 4352 + g]; }
    __syncthreads();
    bf16* H = (bf16*)(ws + WS_H); float* GIF = (float*)(ws + WS_GIF);
    f32x4 pre[8];
    if (gw < T) {
#pragma unroll
        for (int j = 0; j < 8; ++j) pre[j] = __builtin_nontemporal_load((const f32x4*)(x + (size_t)gw * D) + lane + 64 * j);
    }
    for (int m = gw; m < T; m += NGW) {
        f32x4 v[8]; float s = 0.f;
#pragma unroll
        for (int j = 0; j < 8; ++j) { v[j] = pre[j]; s += (v[j][0] + v[j][1]) + (v[j][2] + v[j][3]); }
        if (m + NGW < T) {
#pragma unroll
            for (int j = 0; j < 8; ++j) pre[j] = __builtin_nontemporal_load((const f32x4*)(x + (size_t)(m + NGW) * D) + lane + 64 * j);
        }
        const float mean = wave_sum(s) * (1.f / D); float q = 0.f;
#pragma unroll
        for (int j = 0; j < 8; ++j) { v[j] = v[j] - mean; q += (v[j][0] * v[j][0] + v[j][1] * v[j][1]) + (v[j][2] * v[j][2] + v[j][3] * v[j][3]); }
        const float rstd = rsqrtf(wave_sum(q) * (1.f / D) + LN_EPS);
        float ga[8];
#pragma unroll
        for (int g = 0; g < 8; ++g) ga[g] = 0.f;
#pragma unroll
        for (int j = 0; j < 8; ++j) {
            const f32x4 g4 = ((const f32x4*)ln_g)[lane + 64 * j], b4 = ((const f32x4*)ln_b)[lane + 64 * j];
            const f32x4 y = v[j] * rstd * g4 + b4;
            v2u o; o.x = pk2(y[0], y[1]); o.y = pk2(y[2], y[3]);
            __builtin_nontemporal_store(o, (v2u*)(H + (size_t)m * D + 256 * j + 4 * lane));
            if (FP8_P1) *(unsigned*)(ws + WS_H8 + (size_t)m * D + 256 * j + 4 * lane) = pk4_fp8(y[0], y[1], y[2], y[3]);
#pragma unroll
            for (int g = 0; g < 8; ++g) { const f32x4 w4 = *(const LAS f32x4*)(wif + g * 2048 + 256 * j + 4 * lane); ga[g] += (y[0] * w4[0] + y[1] * w4[1]) + (y[2] * w4[2] + y[3] * w4[3]); }
            asm volatile("" ::: "memory"); __builtin_amdgcn_sched_barrier(0);
        }
#pragma unroll
        for (int g = 0; g < 8; ++g) ga[g] = wave_sum(ga[g]);
        if (lane == 0) { *(f32x4*)(GIF + (size_t)m * 8) = (f32x4){ga[0], ga[1], ga[2], ga[3]}; *(f32x4*)(GIF + (size_t)m * 8 + 4) = (f32x4){ga[4], ga[5], ga[6], ga[7]}; }
    }
    __syncthreads();
}

constexpr int ATT_K_OFF = 0, ATT_KS = 72, ATT_VT_OFF = 256 * 72 * 2, ATT_VS = 264;
__device__ __forceinline__ void attn_unit(Frame& F, int unit, bf16* PROJ, const float* sinks) {
    const int b = unit >> 8, blk = (unit & 255) >> 1, hkv = unit & 1;
    const int tok0 = b * SEQ + blk * 128, ktok0 = tok0 - 128;
    LAS bf16* Ks = (LAS bf16*)(F.lds + RING_OFF + ATT_K_OFF); LAS bf16* Vt = (LAS bf16*)(F.lds + RING_OFF + ATT_VT_OFF);
    for (int pidx = F.tid; pidx < 2048; pidx += 512) {
        const int kj = pidx >> 3, c8 = pidx & 7; int tk = ktok0 + kj; if (blk == 0 && kj < 128) tk = tok0;
        const size_t so = (size_t)tk * 128 + 64 * hkv + 8 * c8;
        const v4u kv = *(const v4u*)(PSEG(PROJ, C_K) + so), vv = *(const v4u*)(PSEG(PROJ, C_V) + so);
        *(LAS v4u*)(Ks + kj * ATT_KS + 8 * c8) = kv;
        LAS bf16* vd = Vt + (8 * c8) * ATT_VS + ((((kj >> 3) ^ c8) << 3) | (kj & 7));
        vd[0 * ATT_VS] = (bf16)(vv.x & 0xffffu); vd[1 * ATT_VS] = (bf16)(vv.x >> 16); vd[2 * ATT_VS] = (bf16)(vv.y & 0xffffu); vd[3 * ATT_VS] = (bf16)(vv.y >> 16);
        vd[4 * ATT_VS] = (bf16)(vv.z & 0xffffu); vd[5 * ATT_VS] = (bf16)(vv.z >> 16); vd[6 * ATT_VS] = (bf16)(vv.w & 0xffffu); vd[7 * ATT_VS] = (bf16)(vv.w >> 16);
    }
    LBAR();
    const int lane = F.lane, fr = lane & 15, fq = lane >> 4, h = hkv * 8 + F.wave;
    const float slope_l2 = fast_exp2(-0.5f * (float)(h + 1)) * LOG2E, sink_l2 = sinks[h] * LOG2E;
    bf16x8 qn[2];
#pragma unroll
    for (int ks = 0; ks < 2; ++ks) qn[ks] = *(const bf16x8*)(PSEG(PROJ, C_Q) + (size_t)(tok0 + fr) * 1024 + 64 * h + 32 * ks + 8 * fq);
    for (int qc = 0; qc < 8; ++qc) {
        const int qi = 16 * qc + fr; bf16* qrow = PSEG(PROJ, C_Q) + (size_t)(tok0 + qi) * 1024 + 64 * h;
        bf16x8 qf[2];
#pragma unroll
        for (int ks = 0; ks < 2; ++ks) qf[ks] = qn[ks];
        if (qc < 7) {
#pragma unroll
            for (int ks = 0; ks < 2; ++ks) qn[ks] = *(const bf16x8*)(qrow + (size_t)16 * 1024 + 32 * ks + 8 * fq);
        }
        const int tb = qc & ~1;
        f32x4 s[10];
#pragma unroll
        for (int tt = 0; tt < 10; ++tt) {
            s[tt] = (f32x4){0.f, 0.f, 0.f, 0.f};
#pragma unroll
            for (int ks = 0; ks < 2; ++ks) { const bf16x8 kf = *(const LAS bf16x8*)(Ks + (16 * (tb + tt) + fr) * ATT_KS + 32 * ks + 8 * fq); s[tt] = __builtin_amdgcn_mfma_f32_16x16x32_bf16(kf, qf[ks], s[tt], 0, 0, 0); }
        }
        float mx = sink_l2;
#pragma unroll
        for (int tt = 0; tt < 10; ++tt)
#pragma unroll
            for (int r = 0; r < 4; ++r) { const int kj = 16 * (tb + tt) + 4 * fq + r; const bool valid = (kj > qi) && (kj <= qi + 128) && (blk > 0 || kj >= 128);
                const float val = s[tt][r] - slope_l2 * (float)(qi + 128 - kj); s[tt][r] = valid ? val : -INFINITY; mx = fmaxf(mx, s[tt][r]); }
        mx = fmaxf(mx, __shfl_xor(mx, 16)); mx = fmaxf(mx, __shfl_xor(mx, 32));
        float l = 0.f;
#pragma unroll
        for (int tt = 0; tt < 10; ++tt)
#pragma unroll
            for (int r = 0; r < 4; ++r) { const float pv = fast_exp2(s[tt][r] - mx); s[tt][r] = pv; l += pv; }
        l += __shfl_xor(l, 16); l += __shfl_xor(l, 32); l += fast_exp2(sink_l2 - mx);
        f32x4 o[4];
#pragma unroll
        for (int dt = 0; dt < 4; ++dt) o[dt] = (f32x4){0.f, 0.f, 0.f, 0.f};
#pragma unroll
        for (int pp = 0; pp < 5; ++pp) {
            v4u pw; pw.x = pk2(s[2 * pp][0], s[2 * pp][1]); pw.y = pk2(s[2 * pp][2], s[2 * pp][3]); pw.z = pk2(s[2 * pp + 1][0], s[2 * pp + 1][1]); pw.w = pk2(s[2 * pp + 1][2], s[2 * pp + 1][3]);
            const bf16x8 pf = __builtin_bit_cast(bf16x8, pw);
            const int kb = 16 * (tb + 2 * pp);
#pragma unroll
            for (int dt = 0; dt < 4; ++dt) {
                const int drow = 16 * dt + fr, dx = (drow >> 3) & 7, k0 = kb + 4 * fq;
                const LAS bf16* vrow_ = Vt + drow * ATT_VS;
                const v2u va = *(const LAS v2u*)(vrow_ + ((((k0 >> 3) ^ dx) << 3) | (k0 & 7))), vb = *(const LAS v2u*)(vrow_ + (((((k0 + 16) >> 3) ^ dx) << 3) | (k0 & 7)));
                v4u vw; vw.x = va.x; vw.y = va.y; vw.z = vb.x; vw.w = vb.y;
                o[dt] = __builtin_amdgcn_mfma_f32_16x16x32_bf16(__builtin_bit_cast(bf16x8, vw), pf, o[dt], 0, 0, 0);
            }
        }
        const float inv = fast_rcp(l);
#pragma unroll
        for (int dt = 0; dt < 4; ++dt) { v2u ov; ov.x = pk2(o[dt][0] * inv, o[dt][1] * inv); ov.y = pk2(o[dt][2] * inv, o[dt][3] * inv); *(v2u*)(qrow + 16 * dt + 4 * fq) = ov; }
    }
    LBAR();
}

__device__ __forceinline__ void mlstm_gates(const float* GIF, const float* b_i, const float* b_f, int t, int h, float& ig, float& lf) {
    const float ip = GIF[(size_t)t * 8 + h] + b_i[h], fp = GIF[(size_t)t * 8 + 4 + h] + b_f[h];
    ig = 15.0f * tanhf(ip * (1.0f / 15.0f));
    const float fc = 15.0f * tanhf(fp * (1.0f / 15.0f));
    lf = fminf(fc, 0.f) - log1pf(expf(-fabsf(fc)));
}
__device__ __forceinline__ float wave_incl_scan_add(float v, int lane) {
#pragma unroll
    for (int o = 1; o < 64; o <<= 1) { const float n = __shfl_up(v, o); if (lane >= o) v += n; }
    return v;
}
__device__ __forceinline__ float wave_incl_scan_max(float v, int lane) {
#pragma unroll
    for (int o = 1; o < 64; o <<= 1) { const float n = __shfl_up(v, o); if (lane >= o) v = fmaxf(v, n); }
    return v;
}
__device__ __forceinline__ int swz72(int r, int sc) { return r * 72 + ((((sc >> 3) ^ ((r >> 3) & 7)) << 3) | (sc & 7)); }
constexpr int ML_S = 72;
__device__ __forceinline__ void mlstm_a_unit(Frame& F, int unit, const bf16* PROJ, const float* GIF, const float* b_i, const float* b_f, bf16* DC, float* SC, float* DN) {
    const int seq = unit >> 8, c = unit & 255, b = seq >> 2, h = seq & 3, t0 = b * SEQ + 64 * c, lane = F.lane;
    LAS bf16* Kt = (LAS bf16*)(F.lds + RING_OFF); LAS bf16* Vt = (LAS bf16*)(F.lds + RING_OFF + 128 * ML_S * 2); LAS float* wgl = (LAS float*)(F.lds + RING_OFF + (128 + 256) * ML_S * 2);
    v4u kvr[2], vvr[4];
#pragma unroll
    for (int k = 0; k < 2; ++k) { const int pidx = F.tid + 512 * k; kvr[k] = *(const v4u*)(PSEG(PROJ, C_MK) + (size_t)(t0 + (pidx >> 4)) * 512 + 128 * h + 8 * (pidx & 15)); }
#pragma unroll
    for (int k = 0; k < 4; ++k) { const int pidx = F.tid + 512 * k; vvr[k] = *(const v4u*)(PSEG(PROJ, C_MV) + (size_t)(t0 + (pidx >> 5)) * 1024 + 256 * h + 8 * (pidx & 31)); }
    if (F.wave == 0) {
        float ig, lf; mlstm_gates(GIF, b_i, b_f, t0 + lane, h, ig, lf);
        const float bc = wave_incl_scan_add(lf, lane), bl = __shfl(bc, 63), g = bl - bc + ig, gmax = wave_max(g);
        wgl[lane] = expf(g - gmax);
        if (lane == 0) { SC[unit * 2] = bl; SC[unit * 2 + 1] = gmax; }
    }
#pragma unroll
    for (int kk = 0; kk < 4; ++kk) {
        const int pidx = F.tid + 512 * kk;
        const int s = pidx >> 5, c8 = pidx & 31;
        const v4u vv = vvr[kk];
        LAS bf16* vd = Vt + (8 * c8) * ML_S + ((((s >> 3) ^ (c8 & 7)) << 3) | (s & 7));
        vd[0 * ML_S] = (bf16)(vv.x & 0xffffu); vd[1 * ML_S] = (bf16)(vv.x >> 16); vd[2 * ML_S] = (bf16)(vv.y & 0xffffu); vd[3 * ML_S] = (bf16)(vv.y >> 16);
        vd[4 * ML_S] = (bf16)(vv.z & 0xffffu); vd[5 * ML_S] = (bf16)(vv.z >> 16); vd[6 * ML_S] = (bf16)(vv.w & 0xffffu); vd[7 * ML_S] = (bf16)(vv.w >> 16);
    }
    LBAR();
#pragma unroll
    for (int kk = 0; kk < 2; ++kk) {
        const int pidx = F.tid + 512 * kk;
        const int s = pidx >> 4, c8 = pidx & 15; const float w = wgl[s];
        const v4u kv = kvr[kk];
        LAS bf16* kd = Kt + (8 * c8) * ML_S + ((((s >> 3) ^ (c8 & 7)) << 3) | (s & 7));
        kd[0 * ML_S] = (bf16)f2bf(bflo(kv.x) * w); kd[1 * ML_S] = (bf16)f2bf(bfhi(kv.x) * w); kd[2 * ML_S] = (bf16)f2bf(bflo(kv.y) * w); kd[3 * ML_S] = (bf16)f2bf(bfhi(kv.y) * w);
        kd[4 * ML_S] = (bf16)f2bf(bflo(kv.z) * w); kd[5 * ML_S] = (bf16)f2bf(bfhi(kv.z) * w); kd[6 * ML_S] = (bf16)f2bf(bflo(kv.w) * w); kd[7 * ML_S] = (bf16)f2bf(bfhi(kv.w) * w);
    }
    LBAR();
    if (F.tid < 128) { float sn = 0.f;
#pragma unroll 8
        for (int s = 0; s < 64; ++s) sn += bf2f(Kt[F.tid * ML_S + s]);
        DN[(size_t)unit * 128 + F.tid] = sn; }
    const int fr = lane & 15, fq = lane >> 4, w = F.wave;
    bf16x8 yf[2][2];
#pragma unroll
    for (int vi = 0; vi < 2; ++vi)
#pragma unroll
        for (int ks = 0; ks < 2; ++ks) yf[vi][ks] = *(const LAS bf16x8*)(Vt + swz72(16 * (2 * w + vi) + fr, 32 * ks + 8 * fq));
    bf16* dst = DC + (size_t)unit * 32768;
#pragma unroll
    for (int dt = 0; dt < 8; ++dt) {
        bf16x8 xf[2];
#pragma unroll
        for (int ks = 0; ks < 2; ++ks) xf[ks] = *(const LAS bf16x8*)(Kt + swz72(16 * dt + fr, 32 * ks + 8 * fq));
#pragma unroll
        for (int vi = 0; vi < 2; ++vi) {
            f32x4 a = zero_acc();
            a = __builtin_amdgcn_mfma_f32_16x16x32_bf16(xf[0], yf[vi][0], a, 0, 0, 0);
            a = __builtin_amdgcn_mfma_f32_16x16x32_bf16(xf[1], yf[vi][1], a, 0, 0, 0);
            v2u o; o.x = pk2(a[0], a[1]); o.y = pk2(a[2], a[3]);
            *(v2u*)(dst + (size_t)(16 * (2 * w + vi) + fr) * 128 + 16 * dt + 4 * fq) = o;
        }
    }
    LBAR();
}
__device__ __forceinline__ void mlstm_scan(Frame& F, bf16* DC, const float* SC, const float* DN, float* NST, float* MS) {
    LAS float* tm = (LAS float*)(F.lds + RING_OFF);
    LAS f32x2* tds = (LAS f32x2*)(F.lds + RING_OFF + 2048);
    for (int base = blockIdx.x * 512; base < 8 * 16384; base += F.G * 512) {
        const int seq = base >> 14; const float* sc = SC + (size_t)seq * 512;
        __syncthreads();
        if (F.wave == 0) {
            const int lane = F.lane; float B[4], Gm[4];
            { const f32x4 s0 = *(const f32x4*)(sc + 8 * lane), s1 = *(const f32x4*)(sc + 8 * lane + 4); B[0] = s0[0]; Gm[0] = s0[1]; B[1] = s0[2]; Gm[1] = s0[3]; B[2] = s1[0]; Gm[2] = s1[1]; B[3] = s1[2]; Gm[3] = s1[3]; }
            float TB = B[0], TG = Gm[0];
#pragma unroll
            for (int k = 1; k < 4; ++k) { TG = fmaxf(TG + B[k], Gm[k]); TB += B[k]; }
            float PB = TB, PG = TG;
#pragma unroll
            for (int o = 1; o < 64; o <<= 1) { const float oB = __shfl_up(PB, o), oG = __shfl_up(PG, o); if (lane >= o) { PG = fmaxf(oG + PB, PG); PB = oB + PB; } }
            float eB = __shfl_up(PB, 1), eG = __shfl_up(PG, 1); if (lane == 0) { eB = 0.f; eG = -INFINITY; }
            float m = fmaxf(0.f + eB, eG);
#pragma unroll
            for (int k = 0; k < 4; ++k) { tm[4 * lane + k] = m; m = fmaxf(m + B[k], Gm[k]); }
            if (lane == 63) tm[256] = m;
        }
        __syncthreads();
        if (F.tid < 256) { const int c = F.tid; const float bl = sc[2 * c], gmax = sc[2 * c + 1], m = tm[c], mn = tm[c + 1]; tds[c] = (f32x2){expf(bl + m - mn), expf(gmax - mn)}; }
        __syncthreads();
        const int pr = (base & 16383) + F.tid;
        unsigned* ptr = (unsigned*)(DC + (size_t)seq * 256 * 32768) + pr;
        float C0 = 0.f, C1 = 0.f;
        unsigned nx[16];
#pragma unroll
        for (int j = 0; j < 16; ++j) nx[j] = ptr[(size_t)j * 16384];
        for (int c0 = 0; c0 < 256; c0 += 16) {
            unsigned d[16];
#pragma unroll
            for (int j = 0; j < 16; ++j) d[j] = nx[j];
            if (c0 + 16 < 256) {
#pragma unroll
                for (int j = 0; j < 16; ++j) nx[j] = ptr[(size_t)(c0 + 16 + j) * 16384];
            }
#pragma unroll
            for (int j = 0; j < 16; ++j) {
                const f32x2 ds_ = tds[c0 + j];
                ptr[(size_t)(c0 + j) * 16384] = pk2(C0, C1);
                C0 = ds_[0] * C0 + ds_[1] * bflo(d[j]); C1 = ds_[0] * C1 + ds_[1] * bfhi(d[j]);
            }
        }
        if ((base & 16383) == 0 && F.tid < 128) {
            const int dd = F.tid; float n = 0.f;
            for (int c0 = 0; c0 < 256; c0 += 32) {
                float dn[32];
#pragma unroll
                for (int j = 0; j < 32; ++j) dn[j] = DN[(size_t)(seq * 256 + c0 + j) * 128 + dd];
#pragma unroll
                for (int j = 0; j < 32; ++j) { const f32x2 ds_ = tds[c0 + j]; NST[(size_t)(seq * 256 + c0 + j) * 128 + dd] = n; n = ds_[0] * n + ds_[1] * dn[j]; }
            }
            MS[seq * 256 + dd] = tm[dd]; MS[seq * 256 + 128 + dd] = tm[128 + dd];
        }
    }
    __syncthreads();
}
constexpr int MC_VT = 0, MC_SQ = 256 * ML_S * 2, MC_SA = MC_SQ + 64 * ML_S * 2, MC_SM = MC_SA + 256, MC_SI = MC_SM + 256, MC_SE = MC_SI + 256, MC_RED = MC_SE + 256, MC_NST = MC_RED + 512, MC_CT = MC_NST + 512, MC_CTS = 136;
__device__ __forceinline__ void mlstm_c_preload(Frame& F, int unit, const bf16* PROJ, const bf16* DC, v4u (&ctr)[8], v4u (&vvr)[4]) {
    const int seq = unit >> 8, c = unit & 255, b = seq >> 2, h = seq & 3, t0 = b * SEQ + 64 * c;
    const bf16* ct = DC + (size_t)unit * 32768;
#pragma unroll
    for (int k = 0; k < 8; ++k) { const int idx = F.tid + 512 * k; ctr[k] = *(const v4u*)(ct + (size_t)(idx >> 4) * 128 + 8 * (idx & 15)); }
#pragma unroll
    for (int k = 0; k < 4; ++k) { const int pidx = F.tid + 512 * k; vvr[k] = *(const v4u*)(PSEG(PROJ, C_MV) + (size_t)(t0 + (pidx >> 5)) * 1024 + 256 * h + 8 * (pidx & 31)); }
}
__device__ __forceinline__ void mlstm_c_unit(Frame& F, int unit, int unit_next, v4u (&ctr)[8], v4u (&vvr)[4], bf16* PROJ, const float* GIF, const float* b_i, const float* b_f, const bf16* DC, const float* NST, const float* MS, const float* norm_g) {
    const int seq = unit >> 8, c = unit & 255, b = seq >> 2, h = seq & 3, t0 = b * SEQ + 64 * c, lane = F.lane, fr = lane & 15, fq = lane >> 4, w = F.wave;
    LAS unsigned char* L = F.lds + RING_OFF;
    LAS bf16* Vt = (LAS bf16*)(L + MC_VT); LAS bf16* SQ = (LAS bf16*)(L + MC_SQ); LAS bf16* CtL = (LAS bf16*)(L + MC_CT);
    LAS float* sA = (LAS float*)(L + MC_SA); LAS float* sM = (LAS float*)(L + MC_SM); LAS float* sSi = (LAS float*)(L + MC_SI); LAS float* sE = (LAS float*)(L + MC_SE); LAS float* red = (LAS float*)(L + MC_RED); LAS float* nl = (LAS float*)(L + MC_NST);
    const int tt = w >> 1, hf = w & 1;
    bf16x8 xq[4], yk[2][4];
    { const bf16* qrow = PSEG(PROJ, C_MQ) + (size_t)(t0 + 16 * tt + fr) * 512 + 128 * h + 8 * fq;
#pragma unroll
      for (int ks = 0; ks < 4; ++ks) xq[ks] = *(const bf16x8*)(qrow + 32 * ks); }
#pragma unroll
    for (int si = 0; si < 2; ++si) { const int st = 2 * hf + si;
        if (st <= tt) { const bf16* krow = PSEG(PROJ, C_MK) + (size_t)(t0 + 16 * st + fr) * 512 + 128 * h + 8 * fq;
#pragma unroll
            for (int ks = 0; ks < 4; ++ks) yk[si][ks] = *(const bf16x8*)(krow + 32 * ks); }
        else {
#pragma unroll
            for (int ks = 0; ks < 4; ++ks) yk[si][ks] = (bf16x8){0, 0, 0, 0, 0, 0, 0, 0}; } }
    const bf16* morow = PSEG(PROJ, C_MO) + (size_t)(t0 + 16 * tt + fr) * 1024 + 256 * h; bf16* mhrow = PSEG(PROJ, C_MV) + (size_t)(t0 + 16 * tt + fr) * 1024 + 256 * h;
    v2u mo[8]; f32x4 ng[8];
#pragma unroll
    for (int vi = 0; vi < 8; ++vi) { const int v0 = 16 * (8 * hf + vi) + 4 * fq; mo[vi] = *(const v2u*)(morow + v0); ng[vi] = *(const f32x4*)(norm_g + 256 * h + v0); }
    if (F.tid < 32) *(LAS f32x4*)(nl + 4 * F.tid) = *(const f32x4*)(NST + (size_t)unit * 128 + 4 * F.tid);
    if (w == 0) {
        float ig, lf; mlstm_gates(GIF, b_i, b_f, t0 + lane, h, ig, lf);
        const float bc = wave_incl_scan_add(lf, lane), a = ig - bc, pm = wave_incl_scan_max(a, lane), mc = MS[unit], Mt = fmaxf(mc, pm);
        sA[lane] = a; sM[lane] = Mt; sSi[lane] = expf(mc - Mt); sE[lane] = expf(-(bc + Mt));
    }
#pragma unroll
    for (int k = 0; k < 4; ++k) { const int pidx = F.tid + 512 * k, s = pidx >> 5, c8 = pidx & 31; const v4u vv = vvr[k];
        LAS bf16* vd = Vt + (8 * c8) * ML_S + ((((s >> 3) ^ (c8 & 7)) << 3) | (s & 7));
        vd[0 * ML_S] = (bf16)(vv.x & 0xffffu); vd[1 * ML_S] = (bf16)(vv.x >> 16); vd[2 * ML_S] = (bf16)(vv.y & 0xffffu); vd[3 * ML_S] = (bf16)(vv.y >> 16);
        vd[4 * ML_S] = (bf16)(vv.z & 0xffffu); vd[5 * ML_S] = (bf16)(vv.z >> 16); vd[6 * ML_S] = (bf16)(vv.w & 0xffffu); vd[7 * ML_S] = (bf16)(vv.w >> 16); }
#pragma unroll
    for (int k = 0; k < 8; ++k) { const int idx = F.tid + 512 * k; *(LAS v4u*)(CtL + (idx >> 4) * MC_CTS + 8 * (idx & 15)) = ctr[k]; }
    if (unit_next >= 0) mlstm_c_preload(F, unit_next, PROJ, DC, ctr, vvr);
    LBAR();
#pragma unroll
    for (int si = 0; si < 2; ++si) {
        const int st = 2 * hf + si;
        f32x4 sv = zero_acc();
        if (st <= tt) {
#pragma unroll
            for (int ks = 0; ks < 4; ++ks) sv = __builtin_amdgcn_mfma_f32_16x16x32_bf16(xq[ks], yk[si][ks], sv, 0, 0, 0);
        }
        const int sidx = 16 * st + fr; const float as = sA[sidx];
#pragma unroll
        for (int r = 0; r < 4; ++r) { const int tix = 16 * tt + 4 * fq + r; const float wv = (sidx <= tix) ? expf(as - sM[tix]) : 0.f; SQ[tix * ML_S + sidx] = (bf16)f2bf(sv[r] * wv); }
    }
    LBAR();
    bf16x8 xf[6];
    { const float sit = sSi[16 * tt + fr];
#pragma unroll
      for (int ks = 0; ks < 4; ++ks) { const v4u qv = __builtin_bit_cast(v4u, xq[ks]); v4u o; o.x = pk2(bflo(qv.x) * sit, bfhi(qv.x) * sit); o.y = pk2(bflo(qv.y) * sit, bfhi(qv.y) * sit);
          o.z = pk2(bflo(qv.z) * sit, bfhi(qv.z) * sit); o.w = pk2(bflo(qv.w) * sit, bfhi(qv.w) * sit); xf[ks] = __builtin_bit_cast(bf16x8, o); }
#pragma unroll
      for (int ks = 0; ks < 2; ++ks) xf[4 + ks] = *(const LAS bf16x8*)(SQ + (16 * tt + fr) * ML_S + 32 * ks + 8 * fq); }
    float nq;
    { f32x4 an = zero_acc();
#pragma unroll
      for (int ks = 0; ks < 6; ++ks) {
          v4u yn = (v4u){0u, 0u, 0u, 0u};
          if (fr == 0) { if (ks < 4) { const f32x4 n0 = *(const LAS f32x4*)(nl + 32 * ks + 8 * fq), n1 = *(const LAS f32x4*)(nl + 32 * ks + 8 * fq + 4); yn = pack8(n0, n1); } else yn = (v4u){0x3f803f80u, 0x3f803f80u, 0x3f803f80u, 0x3f803f80u}; }
          an = __builtin_amdgcn_mfma_f32_16x16x32_bf16(__builtin_bit_cast(bf16x8, yn), xf[ks], an, 0, 0, 0);
      }
      nq = __shfl(an[0], fr); }
    const float den = fmaxf(fabsf(nq), sE[16 * tt + fr]), rden = 1.0f / den;
    f32x4 acc[8];
#pragma unroll
    for (int vi = 0; vi < 8; ++vi) {
        const int vrow = 16 * (8 * hf + vi) + fr;
        f32x4 a = zero_acc();
#pragma unroll
        for (int ks = 0; ks < 4; ++ks) { const bf16x8 yc = *(const LAS bf16x8*)(CtL + vrow * MC_CTS + 32 * ks + 8 * fq); a = __builtin_amdgcn_mfma_f32_16x16x32_bf16(yc, xf[ks], a, 0, 0, 0); }
#pragma unroll
        for (int ks = 0; ks < 2; ++ks) { const bf16x8 yv = *(const LAS bf16x8*)(Vt + swz72(vrow, 32 * ks + 8 * fq)); a = __builtin_amdgcn_mfma_f32_16x16x32_bf16(yv, xf[4 + ks], a, 0, 0, 0); }
        acc[vi] = a * rden;
    }
    float ssq = 0.f;
#pragma unroll
    for (int vi = 0; vi < 8; ++vi) ssq += (acc[vi][0] * acc[vi][0] + acc[vi][1] * acc[vi][1]) + (acc[vi][2] * acc[vi][2] + acc[vi][3] * acc[vi][3]);
    ssq += __shfl_xor(ssq, 16); ssq += __shfl_xor(ssq, 32);
    if (fq == 0) red[(16 * tt + fr) * 2 + hf] = ssq;
    LBAR();
    const float tot = red[(16 * tt + fr) * 2] + red[(16 * tt + fr) * 2 + 1];
    const float rs = rsqrtf(tot * (1.0f / 256.0f) + RMS_EPS);
#pragma unroll
    for (int vi = 0; vi < 8; ++vi) {
        const int v0 = 16 * (8 * hf + vi) + 4 * fq;
        v2u o; o.x = pk2(acc[vi][0] * rs * ng[vi][0] * bflo(mo[vi].x), acc[vi][1] * rs * ng[vi][1] * bfhi(mo[vi].x)); o.y = pk2(acc[vi][2] * rs * ng[vi][2] * bflo(mo[vi].y), acc[vi][3] * rs * ng[vi][3] * bfhi(mo[vi].y));
        *(v2u*)(mhrow + v0) = o;
    }
    LBAR();
}

template <int R, class StF>
__device__ __forceinline__ void ln_multi(const v4u (&rw)[R][4], const float* g, const float* bta, int lane, StF&& st) {
    float v[R][32]; float sm[R], sq[R];
#pragma unroll
    for (int r = 0; r < R; ++r) { sm[r] = 0.f;
#pragma unroll
        for (int j = 0; j < 4; ++j) { f32x4 a, b; unpack8(rw[r][j], a, b);
#pragma unroll
            for (int i = 0; i < 4; ++i) { v[r][8 * j + i] = a[i]; v[r][8 * j + 4 + i] = b[i]; sm[r] += a[i] + b[i]; } } }
#pragma unroll
    for (int o = 1; o < 64; o <<= 1) {
#pragma unroll
        for (int r = 0; r < R; ++r) sm[r] += __shfl_xor(sm[r], o);
    }
#pragma unroll
    for (int r = 0; r < R; ++r) { sm[r] *= (1.f / D); sq[r] = 0.f;
#pragma unroll
        for (int i = 0; i < 32; ++i) { const float d = v[r][i] - sm[r]; sq[r] += d * d; } }
#pragma unroll
    for (int o = 1; o < 64; o <<= 1) {
#pragma unroll
        for (int r = 0; r < R; ++r) sq[r] += __shfl_xor(sq[r], o);
    }
#pragma unroll
    for (int r = 0; r < R; ++r) sq[r] = rsqrtf(sq[r] * (1.f / D) + LN_EPS);
#pragma unroll
    for (int j = 0; j < 4; ++j) {
        const f32x4 g0 = *(const f32x4*)(g + 512 * j + 8 * lane), g1 = *(const f32x4*)(g + 512 * j + 8 * lane + 4), b0 = *(const f32x4*)(bta + 512 * j + 8 * lane), b1 = *(const f32x4*)(bta + 512 * j + 8 * lane + 4);
#pragma unroll
        for (int r = 0; r < R; ++r) { f32x4 a, b;
#pragma unroll
            for (int i = 0; i < 4; ++i) { a[i] = (v[r][8 * j + i] - sm[r]) * sq[r] * g0[i] + b0[i]; b[i] = (v[r][8 * j + 4 + i] - sm[r]) * sq[r] * g1[i] + b1[i]; }
            st(r, j, a, b); }
    }
}
__device__ __forceinline__ void ln_row_inplace(bf16* row, unsigned char* row8, const float* g, const float* bta, int lane, const v4u (&rw)[4]) {
    float v[32];
#pragma unroll
    for (int j = 0; j < 4; ++j) { const v4u w = rw[j]; f32x4 a, b; unpack8(w, a, b);
#pragma unroll
        for (int i = 0; i < 4; ++i) { v[8 * j + i] = a[i]; v[8 * j + 4 + i] = b[i]; } }
    float mean, rstd; ln_stats32(v, mean, rstd);
#pragma unroll
    for (int j = 0; j < 4; ++j) { const f32x4 g0 = *(const f32x4*)(g + 512 * j + 8 * lane), g1 = *(const f32x4*)(g + 512 * j + 8 * lane + 4), b0 = *(const f32x4*)(bta + 512 * j + 8 * lane), b1 = *(const f32x4*)(bta + 512 * j + 8 * lane + 4);
        f32x4 a, b;
#pragma unroll
        for (int i = 0; i < 4; ++i) { a[i] = (v[8 * j + i] - mean) * rstd * g0[i] + b0[i]; b[i] = (v[8 * j + 4 + i] - mean) * rstd * g1[i] + b1[i]; }
        *(v4u*)(row + 512 * j + 8 * lane) = pack8(a, b);
        v2u o8; o8.x = pk4_fp8(a[0], a[1], a[2], a[3]); o8.y = pk4_fp8(b[0], b[1], b[2], b[3]); *(v2u*)(row8 + 512 * j + 8 * lane) = o8; }
}
__device__ __forceinline__ void p7_chunk(Frame& F, int ch, bf16* X1, const float* ln_g, const float* ln_b, const bf16* WR, const float* b_router, int* IDX, float* GW, int* RK, int* HIST) {
    const int lane = F.lane, w = F.wave, fr = lane & 15, fq = lane >> 4;
    const int t = ch * 128 + 16 * w + fr;
    f32x4 lg[4];
#pragma unroll
    for (int et = 0; et < 4; ++et) lg[et] = (f32x4){0.f, 0.f, 0.f, 0.f};
    const bf16* xrow = X1 + (size_t)t * D + 8 * fq;
    constexpr int WRS = 2064;
#pragma unroll 1
    for (int half = 0; half < 2; ++half) {
        if (half) __syncthreads();
        bf16x8 yc[8], yn[8];
#pragma unroll
        for (int ks = 0; ks < 8; ++ks) yc[ks] = *(const bf16x8*)(xrow + 1024 * half + 32 * ks);
#pragma unroll
        for (int kb = 0; kb < 2; ++kb) {
            v4u tmp[8];
#pragma unroll
            for (int k = 0; k < 8; ++k) { const int idx = F.tid + 512 * (kb * 8 + k), e = idx >> 7, c16 = idx & 127; tmp[k] = *(const v4u*)(WR + (size_t)e * D + 1024 * half + 8 * c16); }
#pragma unroll
            for (int k = 0; k < 8; ++k) { const int idx = F.tid + 512 * (kb * 8 + k), e = idx >> 7, c16 = idx & 127; *(LAS v4u*)(F.lds + RING_OFF + e * WRS + 16 * c16) = tmp[k]; }
        }
        __syncthreads();
        LAS const unsigned char* wl = F.lds + RING_OFF + fr * WRS + 16 * fq;
#pragma unroll
        for (int b = 0; b < 4; ++b) {
            if (b < 3) {
#pragma unroll
                for (int ks = 0; ks < 8; ++ks) yn[ks] = *(const bf16x8*)(xrow + 1024 * half + 32 * (8 * (b + 1) + ks));
            }
#pragma unroll
            for (int ks = 0; ks < 8; ++ks) {
#pragma unroll
                for (int et = 0; et < 4; ++et) { const bf16x8 xw = *(const LAS bf16x8*)(wl + (16 * et) * WRS + 64 * (8 * b + ks)); lg[et] = __builtin_amdgcn_mfma_f32_16x16x32_bf16(xw, yc[ks], lg[et], 0, 0, 0); }
            }
            __builtin_amdgcn_sched_barrier(0);
#pragma unroll
            for (int ks = 0; ks < 8; ++ks) yc[ks] = yn[ks];
        }
    }
    __syncthreads();
    float sc[16], sel[16];
#pragma unroll
    for (int et = 0; et < 4; ++et)
#pragma unroll
        for (int r = 0; r < 4; ++r) { float lgv = lg[et][r]; if (!(lgv == lgv)) lgv = 0.f; const float s = 1.0f / (1.0f + expf(-lgv)); sc[et * 4 + r] = s; sel[et * 4 + r] = s + b_router[16 * et + 4 * fq + r]; }
    int eidx[8]; float esc[8]; float ssum = 0.f;
#pragma unroll
    for (int k = 0; k < 8; ++k) {
        float best = -INFINITY; int bi = 0;
#pragma unroll
        for (int i = 0; i < 16; ++i) if (sel[i] > best) { best = sel[i]; bi = i; }
        int be = 16 * (bi >> 2) + 4 * fq + (bi & 3);
#pragma unroll
        for (int off = 16; off <= 32; off <<= 1) { const float ob = __shfl_xor(best, off); const int oe = __shfl_xor(be, off); if (ob > best || (ob == best && oe < be)) { best = ob; be = oe; } }
        const bool owner = ((be >> 2) & 3) == fq; const int li = (be >> 4) * 4 + (be & 3);
        float myv = 0.f;
#pragma unroll
        for (int i = 0; i < 16; ++i) if (owner && i == li) { myv = sc[i]; sel[i] = -INFINITY; }
        myv += __shfl_xor(myv, 16); myv += __shfl_xor(myv, 32);
        eidx[k] = be; esc[k] = myv; ssum += myv;
    }
    const float rn = 2.5f / ssum;
    LAS unsigned char* Etab = (LAS unsigned char*)(F.lds + RING_OFF);
    if (fq == 0) {
        *(int4*)(IDX + (size_t)t * 8) = make_int4(eidx[0], eidx[1], eidx[2], eidx[3]); *(int4*)(IDX + (size_t)t * 8 + 4) = make_int4(eidx[4], eidx[5], eidx[6], eidx[7]);
        *(f32x4*)(GW + (size_t)t * 8) = (f32x4){esc[0] * rn, esc[1] * rn, esc[2] * rn, esc[3] * rn}; *(f32x4*)(GW + (size_t)t * 8 + 4) = (f32x4){esc[4] * rn, esc[5] * rn, esc[6] * rn, esc[7] * rn};
        const unsigned lo = (unsigned)eidx[0] | ((unsigned)eidx[1] << 8) | ((unsigned)eidx[2] << 16) | ((unsigned)eidx[3] << 24), hi = (unsigned)eidx[4] | ((unsigned)eidx[5] << 8) | ((unsigned)eidx[6] << 16) | ((unsigned)eidx[7] << 24);
        *(LAS v2u*)(Etab + (16 * w + fr) * 8) = (v2u){lo, hi};
    }
    __syncthreads();
    int base[8];
#pragma unroll
    for (int ee = 0; ee < 8; ++ee) base[ee] = 0;
#pragma unroll
    for (int half = 0; half < 2; ++half) {
        const int tokl = half * 64 + lane; const v2u e8 = *(const LAS v2u*)(Etab + tokl * 8);
#pragma unroll
        for (int ee = 0; ee < 8; ++ee) {
            const unsigned e = (unsigned)(8 * w + ee); int kk = -1;
#pragma unroll
            for (int k = 0; k < 8; ++k) { const unsigned byte = ((k < 4 ? e8.x : e8.y) >> (8 * (k & 3))) & 0xffu; if (byte == e) kk = k; }
            const unsigned long long mask = __ballot(kk >= 0);
            const int below = __popcll(mask & ((1ull << lane) - 1ull));
            if (kk >= 0) RK[(size_t)(ch * 128 + tokl) * 8 + kk] = base[ee] + below;
            base[ee] += __popcll(mask);
        }
    }
    if (lane == 0) {
#pragma unroll
        for (int ee = 0; ee < 8; ++ee) HIST[ch * 64 + 8 * w + ee] = base[ee];
    }
    __syncthreads();
}
__device__ __forceinline__ void cv_item16(const float* W, int ldw, int n0, unsigned char* WT, size_t dstrow0, int ldk, int k0, int lane) {
    const int g = lane >> 4, c = lane & 15;
    const float* src = W + (size_t)(k0 + 16 * g) * ldw + n0 + 4 * c;
    f32x4 v[16];
#pragma unroll
    for (int kk = 0; kk < 16; ++kk) v[kk] = __builtin_nontemporal_load((const f32x4*)(src + (size_t)kk * ldw));
    unsigned char* dst = WT + (dstrow0 + 4 * c) * (size_t)ldk + k0 + 16 * g;
#pragma unroll
    for (int j = 0; j < 4; ++j) {
        v4u o; unsigned r;
#pragma unroll
        for (int q = 0; q < 4; ++q) {
            r = (unsigned)__builtin_amdgcn_cvt_pk_fp8_f32(v[4 * q][j] * W8_SCALE, v[4 * q + 1][j] * W8_SCALE, 0, false);
            r = (unsigned)__builtin_amdgcn_cvt_pk_fp8_f32(v[4 * q + 2][j] * W8_SCALE, v[4 * q + 3][j] * W8_SCALE, (int)r, true);
            o[q] = r;
        }
        *(v4u*)(dst + (size_t)j * ldk) = o;
    }
}
__device__ __forceinline__ void p7_convert_experts(Frame& F, const float* w_eg, const float* w_eu, const float* w_ed, const float* w_sg, const float* w_su, const float* w_sd) {
    const int gw = F.vcu * NWAVES + F.wave, NGW = F.G * NWAVES, lane = F.lane;
    unsigned char* WGU = F.ws + WS_WGU; unsigned char* WD = F.ws + WS_WD;
    for (int it = gw; it < 65 * 768; it += NGW) {
        const int e = it / 768, r = it % 768, which = r >> 8, q = r & 255;
        if (which < 2) {
            const float* src = (e < 64) ? ((which ? w_eu : w_eg) + (size_t)e * 2048 * 512) : (which ? w_su : w_sg);
            const int kb = q >> 3, nb = q & 7, n0 = 64 * nb;
            cv_item16(src, 512, n0, WGU, (size_t)e * 1024 + (size_t)((n0 >> 7) * 256 + (n0 & 127) + which * 128), 2048, kb * 64, lane);
        } else {
            const float* src = (e < 64) ? (w_ed + (size_t)e * 512 * 2048) : w_sd;
            const int kb = q >> 5, nb = q & 31;
            cv_item16(src, 2048, 64 * nb, WD, (size_t)e * 2048 + 64 * nb, 512, kb * 64, lane);
        }
    }
}
__device__ __forceinline__ void p8_sort(Frame& F, const int* HIST, const int* IDX, const float* GW, const int* RK, int* TOKSLOT, unsigned short* ROWTOK, float* ROWW, int* META, int* TILEE) {
    LAS int* cntl = (LAS int*)(F.lds + RING_OFF); LAS int* pst = cntl + 64; LAS int* basel = pst + 68; LAS int* part = basel + 64;
    { const int e = F.tid & 63, pq = F.tid >> 6; int s = 0;
#pragma unroll 8
      for (int c = 0; c < 32; ++c) s += HIST[(32 * pq + c) * 64 + e];
      part[pq * 64 + e] = s; }
    __syncthreads();
    if (F.tid < 64) { int s = 0;
#pragma unroll
        for (int pq = 0; pq < 8; ++pq) s += part[pq * 64 + F.tid];
        cntl[F.tid] = s; }
    __syncthreads();
    if (F.tid == 0) { int a = 0; for (int e = 0; e < 64; ++e) { pst[e] = a; a += (cntl[e] + 255) & ~255; } pst[64] = a; }
    __syncthreads();
    const int sh0 = pst[64], ntr = sh0 >> 8;
    for (int ch = blockIdx.x; ch < 256; ch += F.G) {
        if (F.tid < 64) { int s = 0; const int pfull = ch >> 5;
            for (int pq = 0; pq < pfull; ++pq) s += part[pq * 64 + F.tid];
            for (int c = pfull * 32; c < ch; ++c) s += HIST[c * 64 + F.tid];
            basel[F.tid] = s; }
        __syncthreads();
        for (int idx = F.tid; idx < 1024; idx += 512) {
            const size_t o = (size_t)(ch * 128) * 8 + idx; const int e = IDX[o] & 63; int slot = pst[e] + basel[e] + RK[o]; slot = slot < 0 ? 0 : (slot >= MAXTILES * 256 ? MAXTILES * 256 - 1 : slot);
            ROWTOK[slot] = (unsigned short)(ch * 128 + (idx >> 3)); ROWW[slot] = GW[o]; TOKSLOT[o] = slot;
        }
        __syncthreads();
    }
    for (int e = blockIdx.x; e < 64; e += F.G) for (int s = pst[e] + cntl[e] + F.tid; s < pst[e + 1]; s += 512) { ROWTOK[s] = 0; ROWW[s] = 0.f; }
    for (int t = blockIdx.x * 512 + F.tid; t < T; t += F.G * 512) { ROWTOK[sh0 + t] = (unsigned short)t; ROWW[sh0 + t] = 1.0f; }
    if (blockIdx.x == 0) {
        if (F.tid == 0) { META[0] = ntr; META[1] = ntr + T / 256; META[2] = sh0; }
        for (int j = F.tid; j < ntr + T / 256; j += 512) { int e = 64; if (j < ntr) { e = 0; for (int k = 0; k < 64; ++k) if (pst[k + 1] <= j * 256) e = k + 1; } TILEE[j] = e; }
    }
    __syncthreads();
}
__device__ __forceinline__ int moe_tables(Frame& F, int shift, bool tokens, const int* META, const int* TILEE, const unsigned short* ROWTOK, bool rev = false) {
    LAS int* etab = (LAS int*)(F.lds + ETAB_OFF); LAS unsigned short* tok = (LAS unsigned short*)(F.lds + TOKTAB_OFF);
    const int ntiles = __builtin_amdgcn_readfirstlane(META[1]);
    for (int i = F.tid; i < 64; i += 512) { const int j = (i * F.G + F.vcu) >> shift; etab[i] = (j < ntiles) ? TILEE[rev ? ntiles - 1 - j : j] : 0; }
    if (tokens) for (int x = F.tid; x < 20 * 256; x += 512) { const int i = x >> 8, j = (i * F.G + F.vcu) >> 2; tok[x] = (j < ntiles) ? ROWTOK[(size_t)j * 256 + (x & 255)] : (unsigned short)0; }
    __syncthreads();
    return ntiles;
}
__device__ __forceinline__ void dec16(v4u w, float (&o)[16]) {
    const unsigned ws_[4] = {w.x, w.y, w.z, w.w};
#pragma unroll
    for (int k = 0; k < 4; ++k) { const f32x2 a = __builtin_amdgcn_cvt_pk_f32_fp8((int)ws_[k], false), b = __builtin_amdgcn_cvt_pk_f32_fp8((int)ws_[k], true); o[4 * k] = a[0]; o[4 * k + 1] = a[1]; o[4 * k + 2] = b[0]; o[4 * k + 3] = b[1]; }
}
__device__ __forceinline__ void combine_chunk(Frame& F, int cc, const bf16* X1, const unsigned char* Y, const int* TOKSLOT, const int* META, bf16* PRE2, const float* ln_g, const float* ln_b) {
    unsigned char* const x28 = F.ws + WS_X8;
    const int gw = F.vcu * NWAVES + F.wave, NGW = F.G * NWAVES, lane = F.lane;
    const int sh0 = __builtin_amdgcn_readfirstlane(META[2]);
    LAS float* lgb = (LAS float*)(F.lds + RING_OFF);
    if (cc == 1) { for (int i = F.tid; i < 2048; i += 512) { lgb[i] = ln_g[i]; lgb[2048 + i] = ln_b[i]; } __syncthreads(); }
    int t = gw;
    int tn = t + NGW;
    int slot_c = TOKSLOT[(size_t)t * 8 + (lane & 7)];
    int slot_n = TOKSLOT[(size_t)(tn < T ? tn : t) * 8 + (lane & 7)];
    v4u yv[9], xa, xb, w0 = (v4u){0, 0, 0, 0}, w1 = (v4u){0, 0, 0, 0};
#define CMB_LOAD(tt, sl, YV, XA, XB, W0, W1) do { \
        _Pragma("unroll") for (int k = 0; k < 8; ++k) { const int slot = __shfl(sl, k); YV[k] = __builtin_nontemporal_load((const v4u*)(Y + (size_t)slot * 1024 + 16 * lane)); } \
        YV[8] = __builtin_nontemporal_load((const v4u*)(Y + (size_t)(sh0 + (tt)) * 1024 + 16 * lane)); \
        { const bf16* xr = X1 + (size_t)(tt) * D + 1024 * cc + 16 * lane; XA = *(const v4u*)xr; XB = *(const v4u*)(xr + 8); } \
        if (cc == 1) { const bf16* pq = PRE2 + (size_t)(tt) * D + 16 * lane; W0 = __builtin_nontemporal_load((const v4u*)pq); W1 = __builtin_nontemporal_load((const v4u*)(pq + 8)); } } while (0)
#define CMB_BODY(tt, YV, XA, XB, W0, W1) do { \
        float a[16]; \
        { f32x4 p, q; unpack8(XA, p, q); \
          _Pragma("unroll") for (int i = 0; i < 4; ++i) { a[i] = p[i] * ALPHA; a[4 + i] = q[i] * ALPHA; } \
          unpack8(XB, p, q); \
          _Pragma("unroll") for (int i = 0; i < 4; ++i) { a[8 + i] = p[i] * ALPHA; a[12 + i] = q[i] * ALPHA; } } \
        float ys[16]; \
        _Pragma("unroll") for (int i = 0; i < 16; ++i) ys[i] = 0.f; \
        _Pragma("unroll") for (int k = 0; k < 9; ++k) { float y[16]; dec16(YV[k], y); \
            _Pragma("unroll") for (int i = 0; i < 16; ++i) ys[i] += y[i]; } \
        _Pragma("unroll") for (int i = 0; i < 16; ++i) a[i] += ys[i] * (1.0f / Y8_SCALE); \
        bf16* pr = PRE2 + (size_t)(tt) * D + 16 * lane; \
        if (cc == 0) { \
            v4u o0, o1; o0.x = pk2(a[0], a[1]); o0.y = pk2(a[2], a[3]); o0.z = pk2(a[4], a[5]); o0.w = pk2(a[6], a[7]); o1.x = pk2(a[8], a[9]); o1.y = pk2(a[10], a[11]); o1.z = pk2(a[12], a[13]); o1.w = pk2(a[14], a[15]); \
            *(v4u*)pr = o0; *(v4u*)(pr + 8) = o1; \
        } else { \
            float v[32]; \
            { f32x4 p, q; unpack8(W0, p, q); \
              _Pragma("unroll") for (int i = 0; i < 4; ++i) { v[i] = p[i]; v[4 + i] = q[i]; } \
              unpack8(W1, p, q); \
              _Pragma("unroll") for (int i = 0; i < 4; ++i) { v[8 + i] = p[i]; v[12 + i] = q[i]; } } \
            _Pragma("unroll") for (int i = 0; i < 16; ++i) v[16 + i] = a[i]; \
            float mean, rstd; ln_stats32(v, mean, rstd); \
            _Pragma("unroll") for (int j = 0; j < 2; ++j) { \
                float o[16]; \
                _Pragma("unroll") for (int q4 = 0; q4 < 4; ++q4) { const f32x4 g4 = *(const LAS f32x4*)(lgb + 1024 * j + 16 * lane + 4 * q4), b4 = *(const LAS f32x4*)(lgb + 2048 + 1024 * j + 16 * lane + 4 * q4); \
                    _Pragma("unroll") for (int i = 0; i < 4; ++i) o[4 * q4 + i] = (v[16 * j + 4 * q4 + i] - mean) * rstd * g4[i] + b4[i]; } \
                v4u o0, o1; o0.x = pk2(o[0], o[1]); o0.y = pk2(o[2], o[3]); o0.z = pk2(o[4], o[5]); o0.w = pk2(o[6], o[7]); o1.x = pk2(o[8], o[9]); o1.y = pk2(o[10], o[11]); o1.z = pk2(o[12], o[13]); o1.w = pk2(o[14], o[15]); \
                *(v4u*)(pr + 1024 * j) = o0; *(v4u*)(pr + 1024 * j + 8) = o1; \
                if (FP8_P14) { v4u o8; o8.x = pk4_fp8(o[0], o[1], o[2], o[3]); o8.y = pk4_fp8(o[4], o[5], o[6], o[7]); o8.z = pk4_fp8(o[8], o[9], o[10], o[11]); o8.w = pk4_fp8(o[12], o[13], o[14], o[15]); *(v4u*)(x28 + (size_t)(tt) * D + 1024 * j + 16 * lane) = o8; } \
            } \
        } } while (0)
    v4u yb[9], xc, xd, w2 = (v4u){0, 0, 0, 0}, w3 = (v4u){0, 0, 0, 0};
    CMB_LOAD(t, slot_c, yv, xa, xb, w0, w1);
    __builtin_amdgcn_s_waitcnt(0x0F70);
    for (;;) {
        const int t2 = tn + NGW;
        const int slot_2 = TOKSLOT[(size_t)(t2 < T ? t2 : t) * 8 + (lane & 7)];
        __builtin_amdgcn_sched_barrier(0);
        CMB_LOAD((tn < T ? tn : t), slot_n, yb, xc, xd, w2, w3);
        __builtin_amdgcn_sched_barrier(0);
        CMB_BODY(t, yv, xa, xb, w0, w1);
        if (tn >= T) break;
        const int t3 = t2 + NGW;
        const int slot_3 = TOKSLOT[(size_t)(t3 < T ? t3 : t) * 8 + (lane & 7)];
        __builtin_amdgcn_sched_barrier(0);
        CMB_LOAD((t2 < T ? t2 : t), slot_2, yv, xa, xb, w0, w1);
        __builtin_amdgcn_sched_barrier(0);
        CMB_BODY(tn, yb, xc, xd, w2, w3);
        if (t2 >= T) break;
        t = t2; tn = t3; slot_n = slot_3;
    }
#undef CMB_BODY
#undef CMB_LOAD
    if (cc == 1) __syncthreads();
}
__device__ __forceinline__ void final_ln(Frame& F, const bf16* PRE3, const float* ln_g, const float* ln_b, float* out) {
    const int gw = F.vcu * NWAVES + F.wave, NGW = F.G * NWAVES, lane = F.lane;
    for (int t0 = gw * 2; t0 < T; t0 += NGW * 2) {
        v4u rw[2][4];
#pragma unroll
        for (int r = 0; r < 2; ++r)
#pragma unroll
            for (int j = 0; j < 4; ++j) rw[r][j] = *(const v4u*)(PRE3 + (size_t)(t0 + r) * D + 512 * j + 8 * lane);
        ln_multi<2>(rw, ln_g, ln_b, lane, [&](int r, int j, const f32x4& a, const f32x4& b) {
            float* o = out + (size_t)(t0 + r) * D + 512 * j + 8 * lane; *(f32x4*)o = a; *(f32x4*)(o + 4) = b; });
    }
}


__device__ __forceinline__ const float* ld_in(int k) {
#if defined(__HIP_DEVICE_COMPILE__)
    auto ka = __builtin_amdgcn_kernarg_segment_ptr(); unsigned long long v;
    asm volatile("s_load_dwordx2 %0, %1, %2\n\ts_waitcnt lgkmcnt(0)" : "=s"(v) : "s"(ka), "s"(k * 8) : "memory");
    return (const float*)(const GAS float*)v;
#else
    return nullptr;
#endif
}

constexpr int CW_BAD = 8;
__device__ __forceinline__ void chk_bf16(Frame& F, const bf16* p, size_t n, int id, unsigned* ctl) {
    bool bad = false;
    for (size_t i = ((size_t)blockIdx.x * 512 + F.tid) * 8; i < n; i += (size_t)F.G * 512 * 8) { const v4u w = *(const v4u*)(p + i);
        const unsigned ws_[4] = {w.x, w.y, w.z, w.w};
#pragma unroll
        for (int k = 0; k < 4; ++k) { if ((ws_[k] & 0x7f80u) == 0x7f80u || (ws_[k] & 0x7f800000u) == 0x7f800000u) bad = true; } }
    if (bad) atomicMax(ctl + CW_BAD, (unsigned)(64 - id));
}
__device__ __forceinline__ void chk_f32(Frame& F, const float* p, size_t n, int id, unsigned* ctl) {
    bool bad = false;
    for (size_t i = (size_t)blockIdx.x * 512 + F.tid; i < n; i += (size_t)F.G * 512) { if ((__float_as_uint(p[i]) & 0x7f800000u) == 0x7f800000u) bad = true; }
    if (bad) atomicMax(ctl + CW_BAD, (unsigned)(64 - id));
}
constexpr int NPHASE = 15;
struct Args { const float* in[28]; float* out; unsigned char* ws; int ph_lo, ph_hi, flags, pad; };
__global__ void __launch_bounds__(NWAVES * 64, 2) fwd(Args args) {
    extern __shared__ __attribute__((aligned(16))) unsigned char lds[];
    Frame F;
    F.lds = (LAS unsigned char*)lds;
    F.tid = threadIdx.x; F.lane = F.tid & 63; F.wave = __builtin_amdgcn_readfirstlane(F.tid >> 6);
    F.G = gridDim.x; { const int bx = blockIdx.x; F.vcu = (F.G % 8 == 0) ? (bx % 8) * (F.G / 8) + bx / 8 : bx; }
    F.ws = args.ws;
    unsigned char* ws = args.ws;
    unsigned* ctl = (unsigned*)(ws + WS_CTL);
    for (int u = F.tid; u < (LDS_BYTES - LDSCTL_OFF) / 4; u += NWAVES * 64) ((LAS unsigned*)(F.lds + LDSCTL_OFF))[u] = 0u;
    __syncthreads();
    const int lo = args.ph_lo, hi = args.ph_hi;
    XcdBarrier bar = xcd_barrier_post(ctl + CW_BAR + lo * XCD_BAR_WORDS, (volatile LAS unsigned*)(F.lds + MISC_OFF));
#ifdef PH_ONLY
#define PH_EN(k) ((k) == PH_ONLY)
#elif defined(PH_MASK)
#define PH_EN(k) (((PH_MASK) >> (k)) & 1)
#else
#define PH_EN(k) 1
#endif
#define IN(k) (PH_EN(k) && lo <= (k) && (k) < hi)
#define SEAM(k) do { if (IN(k) && IN((k) + 1)) xcd_barrier(bar); } while (0)
#define FRESH() do { int t_ = threadIdx.x; asm volatile("" : "+v"(t_)); F.tid = t_; F.lane = t_ & 63; F.wave = __builtin_amdgcn_readfirstlane(t_ >> 6); } while (0)
    bf16* const Hb = (bf16*)(ws + WS_H); bf16* const MG = (bf16*)(ws + WS_MG); bf16* const PROJ = (bf16*)(ws + WS_PROJ); bf16* const DC = (bf16*)(ws + WS_DC);
    float* const GIF = (float*)(ws + WS_GIF); float* const SC = (float*)(ws + WS_SC); float* const MS = (float*)(ws + WS_MS); float* const DN = (float*)(ws + WS_DN); float* const NST = (float*)(ws + WS_NST);
    int* const IDX = (int*)(ws + WS_IDX); float* const GW = (float*)(ws + WS_GW); int* const RK = (int*)(ws + WS_RK); int* const TOKSLOT = (int*)(ws + WS_TOKSLOT); int* const HIST = (int*)(ws + WS_HIST);
    int* const META = (int*)(ws + WS_META); int* const TILEE = (int*)(ws + WS_TILEE); unsigned short* const ROWTOK = (unsigned short*)(ws + WS_ROWTOK); float* const ROWW = (float*)(ws + WS_ROWW);
    unsigned char* const HB = ws + WS_HB; bf16* const Y = (bf16*)(ws + WS_Y); bf16* const PPB = (bf16*)(ws + WS_PPB);
    LAS unsigned char* const ring = F.lds + RING_OFF;
    LAS const unsigned short* const toktab = (LAS const unsigned short*)(F.lds + TOKTAB_OFF);
    LAS const int* const etab = (LAS const int*)(F.lds + ETAB_OFF);

    FRESH();
    if (IN(0)) p0_prologue(F, ld_in(0), ld_in(1), ld_in(2), ld_in(3), ld_in(4), ld_in(9), ld_in(10), ld_in(11), ld_in(14), ld_in(24), ld_in(25));
    SEAM(0);
#ifdef DBG_CHK
    if (IN(1)) { chk_bf16(F, Hb, (size_t)T * D, 1, ctl); chk_f32(F, GIF, (size_t)T * 8, 2, ctl); chk_bf16(F, (const bf16*)(ws + WS_WIN), (size_t)NPROJ * D, 3, ctl); }
#endif
    FRESH();
    if (IN(1)) {
        constexpr int eb = FP8_P1 ? 1 : 2;
        SchedDense S; S.o.init(T / 256, NPROJ / 256, F.G, (int)blockIdx.x); S.A = FP8_P1 ? (const char*)(ws + WS_H8) : (const char*)Hb; S.B = (const char*)(ws + WS_WIN); S.ta = (size_t)256 * D * eb; S.tb = (size_t)256 * D * eb;
        EpiProj E{PROJ};
        pg8::gemm_phase<EpiProj, SchedDense, false, true, FP8_P1 != 0>(ring, D * eb, D * eb, D * eb / 128, S, E, toktab, 127 - 6);
    }
    SEAM(1);
#ifdef DBG_CHK
    if (IN(2)) { chk_bf16(F, PROJ, (size_t)T * NPROJ, 4, ctl); }
#endif
    FRESH();
    if (IN(2)) {
        if (!(args.flags & 2)) for (int u = blockIdx.x; u < 512; u += F.G) attn_unit(F, u, PROJ, ld_in(5));
#ifndef DBG_NO_MLA
        for (int u = blockIdx.x; u < 2048; u += F.G) mlstm_a_unit(F, u, PROJ, GIF, ld_in(6), ld_in(7), DC, SC, DN);
#endif
    }
    SEAM(2);
#ifdef DBG_CHK
    if (IN(3)) { chk_bf16(F, PROJ, (size_t)T * NPROJ, 5, ctl); chk_bf16(F, DC, (size_t)2048 * 32768, 6, ctl); chk_f32(F, SC, 4096, 7, ctl); chk_f32(F, DN, 2048 * 128, 8, ctl); }
#endif
    FRESH();
    if (IN(3)) mlstm_scan(F, DC, SC, DN, NST, MS);
    SEAM(3);
#ifdef DBG_CHK
    if (IN(4)) { chk_bf16(F, DC, (size_t)2048 * 32768, 9, ctl); chk_f32(F, NST, 2048 * 128, 10, ctl); chk_f32(F, MS, 2048, 11, ctl); }
#endif
    FRESH();
    if (IN(4)) {
        v4u ctr[8], vvr[4];
        if ((int)blockIdx.x < 2048) mlstm_c_preload(F, blockIdx.x, PROJ, DC, ctr, vvr);
        for (int u = blockIdx.x; u < 2048; u += F.G) mlstm_c_unit(F, u, (u + F.G < 2048) ? u + F.G : -1, ctr, vvr, PROJ, GIF, ld_in(6), ld_in(7), DC, NST, MS, ld_in(8));
    }
    SEAM(4);
#ifdef DBG_CHK
    if (IN(5)) { chk_bf16(F, PROJ, (size_t)T * NPROJ, 12, ctl); }
#endif
    FRESH();
    if (IN(5)) {
        SchedMerge S; S.o.init(T / 256, D / 256, F.G, (int)blockIdx.x); S.A0 = (const char*)PSEG(PROJ, C_Q); S.A1 = (const char*)PSEG(PROJ, C_MV); S.B0 = (const char*)(ws + WS_WBA); S.B1 = (const char*)(ws + WS_WBM);
        S.ta = (size_t)256 * 1024 * 2; S.tb = (size_t)256 * 1024 * 2; S.cnt = 2;
        EpiMerge E{PROJ, MG};
        const int ntile = (T / 256) * (D / 256) / F.G > 0 ? (T / 256) * (D / 256) / F.G + (((T / 256) * (D / 256)) % F.G ? 1 : 0) : 1;
        const int cls = F.vcu % ntile;
        for (int k = 0; k < ntile; ++k) {
            if (k == cls) { p7_convert_experts(F, ld_in(16), ld_in(17), ld_in(18), ld_in(19), ld_in(20), ld_in(21)); __syncthreads(); }
            S.base = 2 * k;
            pg8::gemm_phase<EpiMerge, SchedMerge, false, true>(ring, 1024 * 2, 1024 * 2, 1024 / 64, S, E, toktab);
        }
    }
    SEAM(5);
#ifdef DBG_CHK
    if (IN(6)) { chk_bf16(F, MG, (size_t)T * D, 13, ctl); }
#endif
    FRESH();
    if (IN(6)) {
        constexpr int eb = FP8_P6 ? 1 : 2;
        const int ncall = ((T / 256) * (D / 256) + F.G - 1) / F.G;
        for (int k = 0; k < ncall; ++k) {
            SchedPanel S{F.G, F.vcu, k, T / 256, (const char*)MG, (const char*)(ws + WS_WOUT), (size_t)256 * D * eb, (size_t)256 * D * eb};
            EpiResidLn E{Hb, ws + WS_X8, ld_in(12), ld_in(13), (unsigned long long*)(ws + WS_LNX2) + (size_t)k * (T / 256) * 256 * 8, ctl + CW_LN2 + k * (T / 256) * 64};
            pg8::gemm_phase<EpiResidLn, SchedPanel, false, false, FP8_P6 != 0>(ring, D * eb, D * eb, D * eb / 128, S, E, toktab, 127 - 9);
        }
    }
    SEAM(6);
#ifdef DBG_CHK
    if (IN(7)) { chk_bf16(F, Hb, (size_t)T * D, 14, ctl); }
#endif
    FRESH();
    if (IN(7)) {
        for (int ch = blockIdx.x; ch < 256; ch += F.G) p7_chunk(F, ch, Hb, ld_in(12), ld_in(13), (const bf16*)(ws + WS_WR), ld_in(15), IDX, GW, RK, HIST);
    }
    SEAM(7);
#ifdef DBG_CHK
    if (IN(8)) { chk_bf16(F, Hb, (size_t)T * D, 15, ctl); chk_f32(F, GW, (size_t)T * 8, 16, ctl);  }
#endif
    FRESH();
    if (IN(8)) p8_sort(F, HIST, IDX, GW, RK, TOKSLOT, ROWTOK, ROWW, META, TILEE);
    SEAM(8);
    FRESH();
    if (IN(9)) {
        const int ntiles = moe_tables(F, 2, true, META, TILEE, ROWTOK);
        SchedGU S{F.G, F.vcu, ntiles, (const char*)(ws + WS_X8), (const char*)(ws + WS_WGU), etab};
        EpiGU E{HB, ROWW};
        pg8::gemm_phase<EpiGU, SchedGU, true, true, true>(ring, D, D, D / 128, S, E, toktab, 127 - 6);
    }
    SEAM(9);
#ifdef DBG_CHK

#endif
    unsigned char* const Y8 = ws + WS_Y;
    for (int c = 0; c < 2; ++c) {
        FRESH();
        if (IN(10 + 2 * c)) {
            const bool rev = (c == 1);
            const int ntiles = moe_tables(F, 2, false, META, TILEE, ROWTOK, rev);
            SchedDown S{F.G, F.vcu, ntiles, c, (const char*)HB, (const char*)(ws + WS_WD), etab, rev};
            EpiStore8 E{Y8, 1024};
            int nt_dn = DE / 128; asm volatile("" : "+s"(nt_dn));
            pg8::gemm_phase<EpiStore8, SchedDown, false, false, true>(ring, DE, DE, nt_dn, S, E, toktab, 127 - 4);
        }
        SEAM(10 + 2 * c);
        FRESH();
        if (IN(11 + 2 * c)) combine_chunk(F, c, Hb, Y8, TOKSLOT, META, MG, ld_in(22), ld_in(23));
        if (c < 1) SEAM(11 + 2 * c);
    }
    FRESH();
    if (IN(13)) {
        SchedDense S; S.o.init(T / 256, D / 256, F.G, (int)blockIdx.x); S.A = (const char*)(ws + WS_PB); S.B = (const char*)(ws + WS_WPP); S.ta = (size_t)256 * 256 * 2; S.tb = (size_t)256 * 256 * 2;
        EpiStore E{PPB, D, 1.0f};
        int nt_pp = 256 / 64; asm volatile("" : "+s"(nt_pp));
        pg8::gemm_phase<EpiStore, SchedDense, false, true>(ring, 256 * 2, 256 * 2, nt_pp, S, E, toktab);
    }
    SEAM(13);
    FRESH();
    if (IN(14)) {
        constexpr int eb = FP8_P14 ? 1 : 2;
        const int ncall = ((T / 256) * (D / 256) + F.G - 1) / F.G;
        for (int k = 0; k < ncall; ++k) {
            SchedPanel S{F.G, F.vcu, k, T / 256, FP8_P14 ? (const char*)(ws + WS_X8) : (const char*)MG, (const char*)(ws + WS_WPG), (size_t)256 * D * eb, (size_t)256 * D * eb};
            EpiPleLn E{MG, PPB, args.out, ld_in(26), ld_in(27), (unsigned long long*)(ws + WS_LNX) + (size_t)k * (T / 256) * 256 * 8, ctl + CW_LN + k * (T / 256) * 64};
            pg8::gemm_phase<EpiPleLn, SchedPanel, false, false, FP8_P14 != 0>(ring, D * eb, D * eb, D * eb / 128, S, E, toktab, 127 - 6);
        }
    }
#undef IN
#undef SEAM
}

#ifndef MK_PER_PHASE
#define MK_PER_PHASE 0
#endif
#ifndef MK_MAXPH
#define MK_MAXPH 15
#endif
extern "C" void kernel_launch(void* const* d_in, const int* in_sizes, int n_in, void* d_out, int out_size, void* d_ws, size_t ws_size, hipStream_t stream) {
    static int grid = 0;
    if (grid == 0) {
        if (n_in != 28 || out_size != T * D || ws_size < WS_END) { fprintf(stderr, "kernel_launch: unexpected problem (n_in %d out %d ws %zu)\n", n_in, out_size, ws_size); grid = -1; return; }
        int dev = 0, cus = 0;
        if (hipGetDevice(&dev) != hipSuccess || hipDeviceGetAttribute(&cus, hipDeviceAttributeMultiprocessorCount, dev) != hipSuccess) { grid = -1; return; }
        if (hipFuncSetAttribute((const void*)fwd, hipFuncAttributeMaxDynamicSharedMemorySize, LDS_BYTES) != hipSuccess) { grid = -1; return; }
        int per_cu = 0;
        (void)hipOccupancyMaxActiveBlocksPerMultiprocessor(&per_cu, (const void*)fwd, NWAVES * 64, LDS_BYTES);
        (void)hipGetLastError();
        grid = cus;
    }
    if (grid < 0) return;
    if (hipMemsetAsync((char*)d_ws + WS_CTL, 0, CTL_ZERO_BYTES, stream) != hipSuccess) return;
    Args a{};
    for (int i = 0; i < 28; ++i) a.in[i] = (const float*)d_in[i];
    a.out = (float*)d_out; a.ws = (unsigned char*)d_ws;
#if MK_PER_PHASE
#ifdef DBG_DUMP
    for (int ph = 0; ph <= DBG_DUMP; ++ph) { a.ph_lo = ph; a.ph_hi = ph + 1; hipLaunchKernelGGL(fwd, dim3(grid), dim3(NWAVES * 64), LDS_BYTES, stream, a); }
    a.ph_lo = 15; a.ph_hi = 16; hipLaunchKernelGGL(fwd, dim3(grid), dim3(NWAVES * 64), LDS_BYTES, stream, a);
#else
    for (int ph = 0; ph < MK_MAXPH; ++ph) { a.ph_lo = ph; a.ph_hi = ph + 1; hipLaunchKernelGGL(fwd, dim3(grid), dim3(NWAVES * 64), LDS_BYTES, stream, a); }
#endif
#else
    a.ph_lo = 0; a.ph_hi = NPHASE; hipLaunchKernelGGL(fwd, dim3(grid), dim3(NWAVES * 64), LDS_BYTES, stream, a);
#ifdef PROBE_PH
    a.ph_lo = PROBE_PH; a.ph_hi = PROBE_PH + 1; a.flags = PROBE_FLAGS; hipLaunchKernelGGL(fwd, dim3(grid), dim3(NWAVES * 64), LDS_BYTES, stream, a);
#endif
#endif
}
```
